# Optimizing an MI355X kernel written in HIP

```python
import math
import jax
import jax.numpy as jnp
from jax import lax
import numpy as np

D_MODEL = 1024
BATCH = 8
SEQ = 4096
DEPTH = 4

N_MIXERS = 2
N_A_LAYERS = (DEPTH + N_MIXERS - 1) // N_MIXERS
N_B_LAYERS = DEPTH // N_MIXERS
RMS_EPS = 1e-6
D_FF = 2816

DIL_PAIRS = ((128, 1), (512, 4), (2048, 16))
N_GROUPS = len(DIL_PAIRS)
HEADS_PER_GROUP = 4
HEAD_DIM_A = 128
ATTN_WIDTH = N_GROUPS * HEADS_PER_GROUP * HEAD_DIM_A
ROPE_THETA = 10000.0

GDN_K_HEADS = 8
GDN_V_HEADS = 16
GDN_HEAD_DIM = 128
GDN_KD = GDN_K_HEADS * GDN_HEAD_DIM
GDN_VD = GDN_V_HEADS * GDN_HEAD_DIM
GDN_CONV_DIM = 2 * GDN_KD + GDN_VD
GDN_PROJ = GDN_CONV_DIM + GDN_VD + 2 * GDN_V_HEADS
GDN_CONV = 4
GDN_CHUNK = 64

kernel_name = "hybrid_dilated_attn_gated_deltanet_macaron"


def rms_norm(x, w):
    xf = x.astype(jnp.float32)
    y = xf * lax.rsqrt(jnp.mean(xf * xf, axis=-1, keepdims=True) + RMS_EPS)
    return (y * w.astype(jnp.float32)).astype(x.dtype)


def swiglu(h, w_in, w_out):
    gu = h @ w_in
    gate, up = gu[..., :D_FF], gu[..., D_FF:]
    return (jax.nn.silu(gate) * up) @ w_out


def rope_tables(seq, dim):
    inv_freq = 1.0 / (ROPE_THETA ** (jnp.arange(0, dim, 2, dtype=jnp.float32) / dim))
    ang = jnp.arange(seq, dtype=jnp.float32)[:, None] * inv_freq[None, :]
    return jnp.cos(ang), jnp.sin(ang)


def apply_rope(x, cos, sin):
    xf = x.astype(jnp.float32)
    half = xf.shape[-1] // 2
    x1, x2 = xf[..., :half], xf[..., half:]
    c, s = cos[None, :, None, :], sin[None, :, None, :]
    return jnp.concatenate([x1 * c - x2 * s, x2 * c + x1 * s], axis=-1).astype(x.dtype)


def dilated_band_attention(q, k, v, dilation, span):
    B, S, H, E = q.shape
    Ls = S // dilation
    nb = -(-Ls // span)
    Lp = nb * span

    def fold(t):
        t = t.reshape(B, Ls, dilation, H, E).transpose(0, 2, 3, 1, 4)
        t = jnp.pad(t, ((0, 0), (0, 0), (0, 0), (0, Lp - Ls), (0, 0)))
        return t.reshape(B, dilation, H, nb, span, E)

    def with_prev(t):
        prev = jnp.pad(t[:, :, :, :-1], ((0, 0), (0, 0), (0, 0), (1, 0), (0, 0), (0, 0)))
        return jnp.concatenate([prev, t], axis=4)

    qb = fold(q)
    kw = with_prev(fold(k))
    vw = with_prev(fold(v))
    s = jnp.einsum('bdhnqe,bdhnke->bdhnqk', qb, kw).astype(jnp.float32)
    blk = jnp.arange(nb)[:, None, None]
    qi = jnp.arange(span)[None, :, None] + span
    kj = jnp.arange(2 * span)[None, None, :]
    dist = qi - kj
    mask = (dist >= 0) & (dist <= span) & (blk * span - span + kj >= 0)
    s = jnp.where(mask, s, -jnp.inf)
    m = jnp.max(s, axis=-1, keepdims=True)
    p = jnp.exp(s - m)
    den = jnp.sum(p, axis=-1, keepdims=True)
    o = jnp.einsum('bdhnqk,bdhnke->bdhnqe', (p / den).astype(v.dtype), vw)
    lse = (m + jnp.log(den))[..., 0]
    o = o.reshape(B, dilation, H, Lp, E)[:, :, :, :Ls].transpose(0, 3, 1, 2, 4).reshape(B, S, H, E)
    lse = lse.reshape(B, dilation, H, Lp)[:, :, :, :Ls].transpose(0, 3, 1, 2).reshape(B, S, H)
    return o, lse


def dilated_attention(h, w_in, w_out, cos, sin):
    B, S, _ = h.shape
    qkv = (h @ w_in).reshape(B, S, 3, N_GROUPS * HEADS_PER_GROUP, HEAD_DIM_A)
    q = apply_rope(qkv[:, :, 0], cos, sin) * (HEAD_DIM_A ** -0.5)
    k = apply_rope(qkv[:, :, 1], cos, sin)
    v = qkv[:, :, 2]
    gshape = (B, S, N_GROUPS, HEADS_PER_GROUP, HEAD_DIM_A)
    q, k, v = q.reshape(gshape), k.reshape(gshape), v.reshape(gshape)
    outs, lses = [], []
    for g, (window, dil) in enumerate(DIL_PAIRS):
        o, l = dilated_band_attention(q[:, :, g], k[:, :, g], v[:, :, g], dil, window // dil)
        outs.append(o)
        lses.append(l)
    alpha = jax.nn.softmax(jnp.stack(lses, axis=2), axis=2)
    o = jnp.stack(outs, axis=2) * alpha[..., None].astype(v.dtype)
    return o.reshape(B, S, ATTN_WIDTH) @ w_out


def causal_depthwise_conv(x, w):
    K = w.shape[0]
    S = x.shape[1]
    xp = jnp.pad(x, ((0, 0), (K - 1, 0), (0, 0)))
    y = xp[:, 0:S] * w[0]
    for j in range(1, K):
        y = y + xp[:, j:j + S] * w[j]
    return y


def l2norm(x):
    xf = x.astype(jnp.float32)
    return xf * lax.rsqrt(jnp.sum(xf * xf, axis=-1, keepdims=True) + 1e-6)


def chunk_gated_delta_rule(q, k, v, g, beta):
    B, S, H, DK = q.shape
    DV = v.shape[-1]
    C = GDN_CHUNK
    nc = S // C

    def chunks4(t):
        return t.reshape(B, nc, C, H, t.shape[-1]).transpose(1, 0, 3, 2, 4)

    def chunks3(t):
        return t.reshape(B, nc, C, H).transpose(1, 0, 3, 2)

    qc, kc, vc = chunks4(q), chunks4(k), chunks4(v)
    gc, bc = chunks3(g), chunks3(beta)
    gcum = jnp.cumsum(gc, axis=-1)
    idx = jnp.arange(C)
    incl = idx[:, None] >= idx[None, :]
    strict = idx[:, None] > idx[None, :]
    diff = gcum[..., :, None] - gcum[..., None, :]
    decay = jnp.where(incl, jnp.exp(jnp.where(incl, diff, 0.0)), 0.0)
    kk = jnp.einsum('nbhie,nbhje->nbhij', kc, kc)
    L = jnp.where(strict, bc[..., :, None] * kk * decay, 0.0)
    rhs = jnp.concatenate([vc * bc[..., None], kc * (bc * jnp.exp(gcum))[..., None]], axis=-1)
    sol = lax.linalg.triangular_solve(jnp.eye(C, dtype=jnp.float32) + L, rhs,
                                      left_side=True, lower=True, unit_diagonal=True)
    u, w = sol[..., :DV], sol[..., DV:]
    qk = jnp.einsum('nbhie,nbhje->nbhij', qc, kc) * decay
    q_dec = qc * jnp.exp(gcum)[..., None]
    k_dec = kc * jnp.exp(gcum[..., -1:] - gcum)[..., None]
    c_dec = jnp.exp(gcum[..., -1])

    def step(state, inp):
        u_c, w_c, qk_c, qd_c, kd_c, cd_c = inp
        v_new = u_c - jnp.einsum('bhce,bhef->bhcf', w_c, state)
        o_c = jnp.einsum('bhce,bhef->bhcf', qd_c, state) + jnp.einsum('bhij,bhjf->bhif', qk_c, v_new)
        state = state * cd_c[..., None, None] + jnp.einsum('bhce,bhcf->bhef', kd_c, v_new)
        return state, o_c

    s0 = jnp.zeros((B, H, DK, DV), jnp.float32)
    _, o = lax.scan(step, s0, (u, w, qk, q_dec, k_dec, c_dec))
    return o.transpose(1, 0, 3, 2, 4).reshape(B, S, H, DV)


def gated_deltanet(h, w_in, conv_w, a_log, dt_bias, norm_w, w_out):
    B, S, _ = h.shape
    E = GDN_HEAD_DIM
    proj = h @ w_in
    qkv = jax.nn.silu(causal_depthwise_conv(proj[..., :GDN_CONV_DIM], conv_w))
    z = proj[..., GDN_CONV_DIM:GDN_CONV_DIM + GDN_VD]
    b = proj[..., GDN_CONV_DIM + GDN_VD:GDN_CONV_DIM + GDN_VD + GDN_V_HEADS]
    a = proj[..., GDN_CONV_DIM + GDN_VD + GDN_V_HEADS:]
    q = qkv[..., :GDN_KD].reshape(B, S, GDN_K_HEADS, E)
    k = qkv[..., GDN_KD:2 * GDN_KD].reshape(B, S, GDN_K_HEADS, E)
    v = qkv[..., 2 * GDN_KD:].reshape(B, S, GDN_V_HEADS, E).astype(jnp.float32)
    rep = GDN_V_HEADS // GDN_K_HEADS
    q = jnp.repeat(l2norm(q), rep, axis=2) * (E ** -0.5)
    k = jnp.repeat(l2norm(k), rep, axis=2)
    beta = jax.nn.sigmoid(b.astype(jnp.float32))
    g = -jnp.exp(a_log.astype(jnp.float32)) * jax.nn.softplus(a.astype(jnp.float32) + dt_bias.astype(jnp.float32))
    o = chunk_gated_delta_rule(q, k, v, g, beta)
    o = rms_norm(o, norm_w) * jax.nn.silu(z.reshape(B, S, GDN_V_HEADS, E).astype(jnp.float32))
    return o.astype(h.dtype).reshape(B, S, GDN_VD) @ w_out


def setup_inputs(seed: int = 0) -> dict:
    key = jax.random.key(seed)
    ks = jax.random.split(key, 16)
    f32 = jnp.float32
    x = jax.random.normal(ks[0], (BATCH, SEQ, D_MODEL), f32)
    norm_w = 1.0 + 0.02 * jax.random.normal(ks[1], (DEPTH, 3, D_MODEL), f32)
    ffn_w_in = jax.random.normal(ks[2], (DEPTH, 2, D_MODEL, 2 * D_FF), f32) * D_MODEL ** -0.5
    ffn_w_out = jax.random.normal(ks[3], (DEPTH, 2, D_FF, D_MODEL), f32) * D_FF ** -0.5
    attn_w_in = jax.random.normal(ks[4], (N_A_LAYERS, D_MODEL, 3 * ATTN_WIDTH), f32) * D_MODEL ** -0.5
    attn_w_out = jax.random.normal(ks[5], (N_A_LAYERS, ATTN_WIDTH, D_MODEL), f32) * ATTN_WIDTH ** -0.5
    gdn_w_in = jax.random.normal(ks[6], (N_B_LAYERS, D_MODEL, GDN_PROJ), f32) * D_MODEL ** -0.5
    gdn_conv_w = jax.random.normal(ks[7], (N_B_LAYERS, GDN_CONV, GDN_CONV_DIM), f32) * GDN_CONV ** -0.5
    gdn_a_log = jnp.log(jax.random.uniform(ks[8], (N_B_LAYERS, GDN_V_HEADS), f32, 1.0, 16.0))
    dt = jnp.exp(jax.random.uniform(ks[9], (N_B_LAYERS, GDN_V_HEADS), f32, math.log(1e-3), math.log(1e-1)))
    gdn_dt_bias = dt + jnp.log(-jnp.expm1(-dt))
    gdn_norm_w = 1.0 + 0.02 * jax.random.normal(ks[10], (N_B_LAYERS, GDN_HEAD_DIM), f32)
    gdn_w_out = jax.random.normal(ks[11], (N_B_LAYERS, GDN_VD, D_MODEL), f32) * GDN_VD ** -0.5
    final_norm_w = 1.0 + 0.02 * jax.random.normal(ks[12], (D_MODEL,), f32)
    return {"x": x, "norm_w": norm_w, "ffn_w_in": ffn_w_in, "ffn_w_out": ffn_w_out,
            "attn_w_in": attn_w_in, "attn_w_out": attn_w_out,
            "gdn_w_in": gdn_w_in, "gdn_conv_w": gdn_conv_w, "gdn_a_log": gdn_a_log,
            "gdn_dt_bias": gdn_dt_bias, "gdn_norm_w": gdn_norm_w, "gdn_w_out": gdn_w_out,
            "final_norm_w": final_norm_w}


def reference(x, norm_w, ffn_w_in, ffn_w_out, attn_w_in, attn_w_out, gdn_w_in, gdn_conv_w,
              gdn_a_log, gdn_dt_bias, gdn_norm_w, gdn_w_out, final_norm_w):
    S = x.shape[1]
    cos, sin = rope_tables(S, HEAD_DIM_A)
    ia, ib = 0, 0
    for i in range(DEPTH):
        x = x + 0.5 * swiglu(rms_norm(x, norm_w[i, 0]), ffn_w_in[i, 0], ffn_w_out[i, 0])
        h = rms_norm(x, norm_w[i, 1])
        if i % N_MIXERS == 0:
            x = x + dilated_attention(h, attn_w_in[ia], attn_w_out[ia], cos, sin)
            ia += 1
        else:
            x = x + gated_deltanet(h, gdn_w_in[ib], gdn_conv_w[ib], gdn_a_log[ib], gdn_dt_bias[ib],
                                   gdn_norm_w[ib], gdn_w_out[ib])
            ib += 1
        x = x + 0.5 * swiglu(rms_norm(x, norm_w[i, 2]), ffn_w_in[i, 1], ffn_w_out[i, 1])
    return rms_norm(x, final_norm_w)
```

```cpp
#include <hip/hip_runtime.h>
#include <hip/hip_cooperative_groups.h>
#include <cstdio>
#include <cstdint>
namespace cg = cooperative_groups;
namespace pg8 {
#define PG8_LAS __attribute__((address_space(3)))
typedef unsigned short bf16_t;
typedef short bf16x8 __attribute__((ext_vector_type(8)));
typedef float f32x4 __attribute__((ext_vector_type(4)));
typedef unsigned u32x4 __attribute__((ext_vector_type(4)));
constexpr int BM = 256, BK = 64, HALF = 128, HTB = HALF * BK * 2  , STAGE_BYTES = 8 * HTB, NXCD = 8, WGM = 8;

__host__ __device__ __forceinline__ int lds_byte(int r, int c) { const int st = (r >> 4) * 2 + (c >> 5), rr = r & 15, cc = c & 31, ob = rr * 64 + cc * 2; return st * 1024 + (ob ^ (((ob >> 9) & 1) << 5)); }
__host__ __device__ __forceinline__ void stage_rc(int b, int& R, int& C) { const int st = b / 1024, sb = b % 1024, swz = sb ^ (((sb >> 9) & 1) << 5); R = (st >> 1) * 16 + swz / 64; C = (st & 1) * 32 + (swz % 64) / 2; }
__host__ __device__ __forceinline__ int perm32(int rho) { const int n = rho >> 4, i = rho & 15; return 8 * (i >> 2) + 4 * n + (i & 3); }

struct Unit { int pm, pn; };
struct Gemm { const bf16_t* A; const bf16_t* Bt; int M, N, K, lda; };

struct StaticOrder {
    int nM, nN, nwg, G, c;
    __host__ __device__ void init(int M, int N, int G_, int c_) { nM = M / BM; nN = N / BM; nwg = nM * nN; G = G_; c = c_; }
    __host__ __device__ bool next(int i, Unit& u) const {
        const long L = (long)i * G + c; if (L >= nwg) return false;
        int wgid = (int)L; { const int q = nwg / NXCD, r = nwg % NXCD, xcd = wgid % NXCD, off = wgid / NXCD; wgid = (xcd < r ? xcd * (q + 1) : r * (q + 1) + (xcd - r) * q) + off; }
        const int nig = WGM * nN, gid = wgid / nig, fm = gid * WGM, gsz = (nM - fm) < WGM ? (nM - fm) : WGM;
        u.pm = fm + ((wgid % nig) % gsz); u.pn = (wgid % nig) / gsz; return true;
    }
    __device__ __forceinline__ void a_ready(const Unit&) const {}
    __device__ __forceinline__ void done(const Unit&) const {}
};
typedef __bf16 bf16x2_cv __attribute__((ext_vector_type(2))); typedef float f32x2_cv __attribute__((ext_vector_type(2)));
__device__ __forceinline__ unsigned cvt_pk_bf16(float lo, float hi) { const f32x2_cv v = {lo, hi}; return __builtin_bit_cast(unsigned, __builtin_convertvector(v, bf16x2_cv)); }
template <class Epi, class Sched, bool ALIGN_EPI = false, bool SP2 = false>
__device__ __forceinline__ void gemm_phase(PG8_LAS unsigned char* lds, const Gemm g, const Sched& S, const Epi& E, int wave_sgpr) {
    int tid_ = (wave_sgpr * 64 + (int)__builtin_amdgcn_mbcnt_hi(~0u, __builtin_amdgcn_mbcnt_lo(~0u, 0u))); asm volatile("" : "+v"(tid_)); const int tid = tid_, wid = __builtin_amdgcn_readfirstlane(tid >> 6), lane = tid & 63, wr = wid >> 2, wc = wid & 3, fr = lane & 15, fq = lane >> 4;
    const int K = g.K, nt = K / BK;
    unsigned voffA[2], voffB[2];
#pragma unroll
    for (int i = 0; i < 2; ++i) { int R, C; stage_rc(tid * 16 + i * 8192, R, C); const int Rb = Epi::PERM ? ((R & ~31) + perm32(R & 31)) : R;
        voffA[i] = (unsigned)(R * g.lda + C) * 2u; voffB[i] = (unsigned)(Rb * K + C) * 2u; }
    const size_t kstep = (size_t)(BK * 2);
    const size_t hstep = (size_t)HALF * K * 2;
    const size_t tstep = 2 * hstep; const size_t hstepA = (size_t)HALF * g.lda * 2, tstepA = 2 * hstepA;
    const unsigned ldsw = (unsigned)wid * 1024u;
    const int aoff = lds_byte(wr * 64 + fr, fq * 8), boff = lds_byte(wc * 32 + fr, fq * 8);
#define PG8_SA(b, h) (((b) * 2 + (h)) * HTB)
#define PG8_SB(b, h) ((4 + (b) * 2 + (h)) * HTB)
#define PG8_STAGE(bufoff, gbase, voff) do { _Pragma("unroll") for (int _i = 0; _i < 2; ++_i) \
        __builtin_amdgcn_global_load_lds((const unsigned*)((const char*)(gbase) + (voff)[_i]), (PG8_LAS unsigned*)(lds + (bufoff) + ldsw + _i * 8192), 16, 0, 0); } while (0)
#define PG8_LDA(dst, b, h) do { _Pragma("unroll") for (int m = 0; m < 4; ++m) _Pragma("unroll") for (int k = 0; k < 2; ++k) dst[m][k] = *(const PG8_LAS bf16x8*)(lds + PG8_SA(b, h) + aoff + m * 2048 + k * 1024); } while (0)
#define PG8_LDB(dst, b, h) do { _Pragma("unroll") for (int n = 0; n < 2; ++n) _Pragma("unroll") for (int k = 0; k < 2; ++k) dst[n][k] = *(const PG8_LAS bf16x8*)(lds + PG8_SB(b, h) + boff + n * 2048 + k * 1024); } while (0)
#define PG8_MMA(ai, bj, At, Bt) do { __builtin_amdgcn_s_setprio(1); _Pragma("unroll") for (int m = 0; m < 4; ++m) _Pragma("unroll") for (int n = 0; n < 2; ++n) _Pragma("unroll") for (int k = 0; k < 2; ++k) \
        acc[ai][bj][m][n] = __builtin_amdgcn_mfma_f32_16x16x32_bf16(Bt[n][k], At[m][k], acc[ai][bj][m][n], 0, 0, 0); __builtin_amdgcn_s_setprio(0); } while (0)
#define PG8_WAIT_V(n) asm volatile("s_waitcnt vmcnt(" #n ")" ::: "memory")
#define PG8_WAIT_L(n) asm volatile("s_waitcnt lgkmcnt(" #n ")" ::: "memory")
#define PG8_BAR __builtin_amdgcn_s_barrier()
#define PG8_SCHED __builtin_amdgcn_sched_barrier(0)
    Unit cur, nxt; int ui = 0;
    if (!S.next(0, cur)) return;
    f32x4 acc[2][2][4][2];
#pragma unroll
    for (int a = 0; a < 2; ++a)
#pragma unroll
        for (int b = 0; b < 2; ++b)
#pragma unroll
            for (int m = 0; m < 4; ++m)
#pragma unroll
                for (int n = 0; n < 2; ++n) acc[a][b][m][n] = (f32x4){0.f, 0.f, 0.f, 0.f};
    bf16x8 At[4][2], B0[2][2], B1[2][2];
    const char* cA = (const char*)g.A + (size_t)cur.pm * tstepA; const char* cB = (const char*)g.Bt + (size_t)cur.pn * tstep;
    S.a_ready(cur);
    if constexpr (SP2) {
        PG8_STAGE(PG8_SB(0, 0), cB, voffB); PG8_STAGE(PG8_SB(0, 1), cB + hstep, voffB); PG8_STAGE(PG8_SA(0, 0), cA, voffA); PG8_STAGE(PG8_SA(0, 1), cA + hstepA, voffA);
        if (wr == 1) PG8_BAR;
        PG8_WAIT_V(2); PG8_BAR;
        PG8_STAGE(PG8_SB(1, 0), cB + kstep, voffB); PG8_STAGE(PG8_SA(1, 0), cA + kstep, voffA); PG8_STAGE(PG8_SB(1, 1), cB + hstep + kstep, voffB);
        PG8_WAIT_V(6); PG8_BAR;
    } else {
        PG8_STAGE(PG8_SB(0, 0), cB, voffB); PG8_STAGE(PG8_SA(0, 0), cA, voffA); PG8_STAGE(PG8_SB(0, 1), cB + hstep, voffB); PG8_STAGE(PG8_SA(0, 1), cA + hstepA, voffA);
        if (wr == 1) PG8_BAR;
        PG8_WAIT_V(4); PG8_BAR;
        PG8_STAGE(PG8_SB(1, 0), cB + kstep, voffB); PG8_STAGE(PG8_SA(1, 0), cA + kstep, voffA); PG8_STAGE(PG8_SB(1, 1), cB + hstep + kstep, voffB);
        PG8_WAIT_V(6); PG8_BAR;
    }
    for (;;) {
        const bool has_next = S.next(ui + 1, nxt);
        const char* nA = has_next ? (const char*)g.A + (size_t)nxt.pm * tstepA : cA; const char* nB = has_next ? (const char*)g.Bt + (size_t)nxt.pn * tstep : cB;
        for (int t = 0; t < nt; t += 2) {
            const bool last = (t == nt - 2);
            const char* a1 = cA + (size_t)(t + 1) * kstep;
            const char* a2 = last ? nA : cA + (size_t)(t + 2) * kstep; const char* b2 = last ? nB : cB + (size_t)(t + 2) * kstep;
            const char* a3 = a2 + kstep; const char* b3 = b2 + kstep;
            if (last && has_next) S.a_ready(nxt);
            if constexpr (SP2) {
            PG8_LDB(B0, 0, 0); PG8_LDB(B1, 0, 1); PG8_SCHED; PG8_LDA(At, 0, 0); PG8_STAGE(PG8_SA(1, 1), a1 + hstepA, voffA);
            PG8_WAIT_V(8); PG8_WAIT_L(0); PG8_BAR; PG8_MMA(0, 0, At, B0); PG8_MMA(0, 1, At, B1); PG8_BAR; PG8_SCHED;
            PG8_LDA(At, 0, 1); PG8_STAGE(PG8_SB(0, 0), b2, voffB); PG8_STAGE(PG8_SB(0, 1), b2 + hstep, voffB); PG8_STAGE(PG8_SA(0, 0), a2, voffA);
            PG8_WAIT_V(8); PG8_WAIT_L(0); PG8_BAR; PG8_MMA(1, 0, At, B0); PG8_MMA(1, 1, At, B1); PG8_BAR; PG8_SCHED;
            PG8_LDB(B0, 1, 0); PG8_LDB(B1, 1, 1); PG8_SCHED; PG8_LDA(At, 1, 0); PG8_STAGE(PG8_SA(0, 1), a2 + hstepA, voffA);
            PG8_WAIT_V(8); PG8_WAIT_L(0); PG8_BAR; PG8_MMA(0, 0, At, B0); PG8_MMA(0, 1, At, B1); PG8_BAR; PG8_SCHED;
            PG8_LDA(At, 1, 1); PG8_STAGE(PG8_SB(1, 0), b3, voffB); PG8_STAGE(PG8_SB(1, 1), b3 + hstep, voffB); PG8_STAGE(PG8_SA(1, 0), a3, voffA);
            PG8_WAIT_V(8); PG8_WAIT_L(0); PG8_BAR; PG8_MMA(1, 0, At, B0); PG8_MMA(1, 1, At, B1); PG8_BAR; PG8_SCHED;
            } else {
            PG8_LDB(B0, 0, 0); PG8_SCHED; PG8_LDA(At, 0, 0); PG8_STAGE(PG8_SA(1, 1), a1 + hstepA, voffA);
            PG8_WAIT_L(8); PG8_BAR; PG8_WAIT_L(0); PG8_MMA(0, 0, At, B0); PG8_BAR; PG8_SCHED;
            PG8_LDB(B1, 0, 1); PG8_STAGE(PG8_SB(0, 0), b2, voffB);
            PG8_BAR; PG8_WAIT_L(0); PG8_MMA(0, 1, At, B1); PG8_BAR;
            PG8_LDA(At, 0, 1); PG8_STAGE(PG8_SA(0, 0), a2, voffA);
            PG8_BAR; PG8_WAIT_L(0); PG8_MMA(1, 0, At, B0); PG8_BAR; PG8_SCHED;
            PG8_STAGE(PG8_SB(0, 1), b2 + hstep, voffB);
            PG8_WAIT_V(6); PG8_BAR; PG8_MMA(1, 1, At, B1); PG8_BAR;
            PG8_LDB(B0, 1, 0); PG8_SCHED; PG8_LDA(At, 1, 0); PG8_STAGE(PG8_SA(0, 1), a2 + hstepA, voffA);
            PG8_WAIT_L(8); PG8_BAR; PG8_WAIT_L(0); PG8_MMA(0, 0, At, B0); PG8_BAR; PG8_SCHED;
            PG8_LDB(B1, 1, 1); PG8_STAGE(PG8_SB(1, 0), b3, voffB);
            PG8_BAR; PG8_WAIT_L(0); PG8_MMA(0, 1, At, B1); PG8_BAR;
            PG8_LDA(At, 1, 1); PG8_STAGE(PG8_SA(1, 0), a3, voffA);
            PG8_BAR; PG8_WAIT_L(0); PG8_MMA(1, 0, At, B0); PG8_BAR; PG8_SCHED;
            PG8_STAGE(PG8_SB(1, 1), b3 + hstep, voffB);
            PG8_WAIT_V(6); PG8_BAR; PG8_MMA(1, 1, At, B1); PG8_BAR;
            }
        }
        if constexpr (ALIGN_EPI) { if (wr == 0) PG8_BAR; }
        if constexpr (!Epi::AFTER_DRAIN) { E(acc, cur, wr, wc, fr, fq); S.done(cur); }
        if (!has_next) break;
#pragma unroll
        for (int a = 0; a < 2; ++a)
#pragma unroll
            for (int b = 0; b < 2; ++b)
#pragma unroll
                for (int m = 0; m < 4; ++m)
#pragma unroll
                    for (int n = 0; n < 2; ++n) acc[a][b][m][n] = (f32x4){0.f, 0.f, 0.f, 0.f};
        cur = nxt; cA = nA; cB = nB; ++ui;
        if constexpr (ALIGN_EPI) { if (wr == 1) PG8_BAR; }
    }
    PG8_WAIT_V(0);
    if constexpr (!ALIGN_EPI) { if (wr == 0) PG8_BAR; }
    PG8_BAR;
    if constexpr (Epi::AFTER_DRAIN) { E.fused(acc, cur, wr, wc, fr, fq, lds, wid, lane); S.done(cur); }
#undef PG8_SA
#undef PG8_SB
#undef PG8_STAGE
#undef PG8_LDA
#undef PG8_LDB
#undef PG8_MMA
#undef PG8_WAIT_V
#undef PG8_WAIT_L
#undef PG8_BAR
#undef PG8_SCHED
}
}

#define LAS __attribute__((address_space(3)))
typedef unsigned short bf16_t;
typedef short bf16x8 __attribute__((ext_vector_type(8)));
typedef float f32x4 __attribute__((ext_vector_type(4)));
typedef float f32x2 __attribute__((ext_vector_type(2)));
typedef unsigned u32x4 __attribute__((ext_vector_type(4)));
typedef unsigned u32x2 __attribute__((ext_vector_type(2)));

constexpr int SEQ = 4096, NB = 8, MTOK = NB * SEQ, DM = 1024, DFF = 2816, NFF = 2 * DFF, DEPTH = 4;
constexpr int AW = 1536, NA = 3 * AW, HD = 128;
constexpr int GKD = 1024, GVD = 2048, GCONV = 4096, NGSRC = 6176, NGP = 6400, PPITCH = 6144;
constexpr float RMS_EPS = 1e-6f;
constexpr int NTHREADS = 512, NWAVES = 8;
constexpr int LDS_BYTES = 160 * 1024;

constexpr size_t MiB = 1u << 20;
constexpr size_t WS_SSQ = 0;
constexpr size_t WS_ROPE = 4 * MiB;
constexpr size_t WS_BA = 6 * MiB;
constexpr size_t WS_XB = 10 * MiB;
constexpr size_t WS_W = 74 * MiB;
constexpr size_t WS_BIG = 266 * MiB;
constexpr size_t WS_AO = 554 * MiB;
constexpr size_t WS_DUMMY = 650 * MiB;
constexpr size_t WS_XBAR = 651 * MiB;
constexpr size_t WS_XL = 652 * MiB;
constexpr size_t WS_HALO_UNUSED = 0;
constexpr size_t WS_END = 684 * MiB;
constexpr size_t W_FFNIN = 0, SZ_FFNIN = (size_t)NFF * DM;
constexpr size_t W_FFNOUT = W_FFNIN + 8 * SZ_FFNIN, SZ_FFNOUT = (size_t)DM * DFF;
constexpr size_t W_ATTNIN = W_FFNOUT + 8 * SZ_FFNOUT, SZ_ATTNIN = (size_t)NA * DM;
constexpr size_t W_ATTNOUT = W_ATTNIN + 2 * SZ_ATTNIN, SZ_ATTNOUT = (size_t)DM * AW;
constexpr size_t W_GDNIN = W_ATTNOUT + 2 * SZ_ATTNOUT, SZ_GDNIN = (size_t)NGP * DM;
constexpr size_t W_GDNOUT = W_GDNIN + 2 * SZ_GDNIN, SZ_GDNOUT = (size_t)DM * GVD;
constexpr size_t W_TOTAL = W_GDNOUT + 2 * SZ_GDNOUT;
static_assert(WS_W + W_TOTAL * 2 <= WS_BIG, "weights fit");
static_assert(WS_BIG + (size_t)MTOK * PPITCH * 2 <= WS_END && WS_BIG + (size_t)MTOK * NA * 2 <= WS_AO && WS_AO + (size_t)MTOK * AW * 2 <= WS_END, "big region");

__device__ __forceinline__ float bf_lo(unsigned w) { return __uint_as_float(w << 16); }
__device__ __forceinline__ float bf_hi(unsigned w) { return __uint_as_float(w & 0xffff0000u); }
__device__ __forceinline__ unsigned pk2(float lo, float hi) { return pg8::cvt_pk_bf16(lo, hi); }
typedef unsigned long long u64;
__device__ __forceinline__ float rstd_of(const u64* ssq, int row) { return rsqrtf((float)ssq[row] * (1.0f / (1048576.0f * DM)) + RMS_EPS); }
__device__ __forceinline__ float fexp(float x) { return __builtin_amdgcn_exp2f(x * 1.4426950408889634f); }
__device__ __forceinline__ float silu_f(float x) { return x * __builtin_amdgcn_rcpf(1.0f + __builtin_amdgcn_exp2f(x * -1.4426950408889634f)); }

struct EpiFfnIn {
    static constexpr bool PERM = true, AFTER_DRAIN = false;
    bf16_t* act; const u64* ssq;
    __device__ __forceinline__ void operator()(const f32x4 (&acc)[2][2][4][2], const pg8::Unit& u, int wr, int wc, int fr, int fq) const {
        const int row0 = u.pm * 256 + wr * 64 + fr, col0 = u.pn * 128 + wc * 32 + 8 * fq;
#pragma unroll
        for (int ai = 0; ai < 2; ++ai)
#pragma unroll
            for (int m = 0; m < 4; ++m) {
                const int row = row0 + ai * 128 + m * 16;
                const float rstd = rstd_of(ssq, row);
                const f32x4 g0 = acc[ai][0][m][0] * rstd, g1 = acc[ai][0][m][1] * rstd, u0 = acc[ai][1][m][0] * rstd, u1 = acc[ai][1][m][1] * rstd;
                u32x4 w;
                w.x = pk2(silu_f(g0[0]) * u0[0], silu_f(g0[1]) * u0[1]); w.y = pk2(silu_f(g0[2]) * u0[2], silu_f(g0[3]) * u0[3]);
                w.z = pk2(silu_f(g1[0]) * u1[0], silu_f(g1[1]) * u1[1]); w.w = pk2(silu_f(g1[2]) * u1[2], silu_f(g1[3]) * u1[3]);
                *(u32x4*)(act + (size_t)row * DFF + col0) = w;
            }
    }
};
struct EpiResid {
    static constexpr bool PERM = true, AFTER_DRAIN = false;
    const float* xin; bf16_t* xh; unsigned char* xl; u64* ssqn; float scale; int first;
    __device__ __forceinline__ void operator()(const f32x4 (&acc)[2][2][4][2], const pg8::Unit& u, int wr, int wc, int fr, int fq) const {
        const int row0 = u.pm * 256 + wr * 64 + fr, col0 = u.pn * 256 + wc * 32 + 8 * fq;
#pragma unroll
        for (int ai = 0; ai < 2; ++ai)
#pragma unroll
            for (int m = 0; m < 4; ++m) {
                const int row = row0 + ai * 128 + m * 16; float ss = 0.f;
#pragma unroll
                for (int bj = 0; bj < 2; ++bj) {
                    const size_t off = (size_t)row * DM + col0 + bj * 128;
                    f32x4 a, b;
                    if (first) { a = *(const f32x4*)(xin + off); b = *(const f32x4*)(xin + off + 4); }
                    else {
                        const u32x4 h = *(const u32x4*)(xh + off); const u32x2 l = *(const u32x2*)(xl + off);
                        const f32x2 l0 = __builtin_amdgcn_cvt_pk_f32_fp8((int)l.x, false), l1 = __builtin_amdgcn_cvt_pk_f32_fp8((int)l.x, true), l2 = __builtin_amdgcn_cvt_pk_f32_fp8((int)l.y, false), l3 = __builtin_amdgcn_cvt_pk_f32_fp8((int)l.y, true);
                        a = (f32x4){bf_lo(h.x) + l0.x * 0.00390625f, bf_hi(h.x) + l0.y * 0.00390625f, bf_lo(h.y) + l1.x * 0.00390625f, bf_hi(h.y) + l1.y * 0.00390625f};
                        b = (f32x4){bf_lo(h.z) + l2.x * 0.00390625f, bf_hi(h.z) + l2.y * 0.00390625f, bf_lo(h.w) + l3.x * 0.00390625f, bf_hi(h.w) + l3.y * 0.00390625f};
                    }
                    a = a + acc[ai][bj][m][0] * scale; b = b + acc[ai][bj][m][1] * scale;
                    u32x4 w; w.x = pk2(a[0], a[1]); w.y = pk2(a[2], a[3]); w.z = pk2(b[0], b[1]); w.w = pk2(b[2], b[3]);
                    *(u32x4*)(xh + off) = w;
#define LO8(x, hbits) fminf(fmaxf(((x) - (hbits)) * 256.0f, -400.f), 400.f)
                    int q0 = 0, q1 = 0;
                    q0 = __builtin_amdgcn_cvt_pk_fp8_f32(LO8(a[0], bf_lo(w.x)), LO8(a[1], bf_hi(w.x)), q0, false); q0 = __builtin_amdgcn_cvt_pk_fp8_f32(LO8(a[2], bf_lo(w.y)), LO8(a[3], bf_hi(w.y)), q0, true);
                    q1 = __builtin_amdgcn_cvt_pk_fp8_f32(LO8(b[0], bf_lo(w.z)), LO8(b[1], bf_hi(w.z)), q1, false); q1 = __builtin_amdgcn_cvt_pk_fp8_f32(LO8(b[2], bf_lo(w.w)), LO8(b[3], bf_hi(w.w)), q1, true);
#undef LO8
                    *(u32x2*)(xl + off) = (u32x2){(unsigned)q0, (unsigned)q1};
                    ss += (a[0] * a[0] + a[1] * a[1]) + (a[2] * a[2] + a[3] * a[3]) + (b[0] * b[0] + b[1] * b[1]) + (b[2] * b[2] + b[3] * b[3]);
                }
                ss += __shfl_xor(ss, 16); ss += __shfl_xor(ss, 32);
                if (fq == 0) atomicAdd(ssqn + row, (u64)(ss * 1048576.0f));
            }
    }
};
struct EpiAttnIn {
    static constexpr bool PERM = true, AFTER_DRAIN = false;
    bf16_t* qkv; const u64* ssq; const float* rope;
    __device__ __forceinline__ void operator()(const f32x4 (&acc)[2][2][4][2], const pg8::Unit& u, int wr, int wc, int fr, int fq) const {
        const int row0 = u.pm * 256 + wr * 64 + fr, colt = u.pn * 256, col0 = colt + wc * 32 + 8 * fq;
        const bool rot = colt < 2 * AW; const int i0 = 16 * wc + 4 * fq;
#pragma unroll
        for (int ai = 0; ai < 2; ++ai)
#pragma unroll
            for (int m = 0; m < 4; ++m) {
                const int row = row0 + ai * 128 + m * 16, pos = row & (SEQ - 1);
                const float rstd = rstd_of(ssq, row);
                f32x4 c = {1.f, 1.f, 1.f, 1.f}, s = {0.f, 0.f, 0.f, 0.f};
                if (rot) { c = *(const f32x4*)(rope + (size_t)pos * 64 + i0); s = *(const f32x4*)(rope + (size_t)SEQ * 64 + (size_t)pos * 64 + i0); }
#pragma unroll
                for (int bj = 0; bj < 2; ++bj) {
                    const f32x4 v0 = acc[ai][bj][m][0] * rstd, v1 = acc[ai][bj][m][1] * rstd;
                    const f32x4 o0 = v0 * c - v1 * s, o1 = v1 * c + v0 * s;
                    u32x4 w; w.x = pk2(o0[0], o0[1]); w.y = pk2(o0[2], o0[3]); w.z = pk2(o1[0], o1[1]); w.w = pk2(o1[2], o1[3]);
                    *(u32x4*)(qkv + (size_t)row * NA + col0 + bj * 128) = w;
                }
            }
    }
};
struct EpiGdnIn {
    static constexpr bool PERM = true, AFTER_DRAIN = false;
    bf16_t* proj; float* ba; const u64* ssq; bf16_t* halo;
    __device__ __forceinline__ void operator()(const f32x4 (&acc)[2][2][4][2], const pg8::Unit& u, int wr, int wc, int fr, int fq) const {
        const int row0 = u.pm * 256 + wr * 64 + fr, col0 = u.pn * 256 + wc * 32 + 8 * fq;
        const bool tail = (u.pn * 256 >= PPITCH);
#pragma unroll
        for (int ai = 0; ai < 2; ++ai)
#pragma unroll
            for (int m = 0; m < 4; ++m) {
                const int row = row0 + ai * 128 + m * 16;
                const float rstd = rstd_of(ssq, row);
                if (!tail) {
#pragma unroll
                    for (int bj = 0; bj < 2; ++bj) {
                        const f32x4 v0 = acc[ai][bj][m][0] * rstd, v1 = acc[ai][bj][m][1] * rstd;
                        u32x4 w; w.x = pk2(v0[0], v0[1]); w.y = pk2(v0[2], v0[3]); w.z = pk2(v1[0], v1[1]); w.w = pk2(v1[2], v1[3]);
                        *(u32x4*)(proj + (size_t)row * PPITCH + col0 + bj * 128) = w;
                        if (fr >= 13 && u.pn * 256 < GCONV) *(u32x4*)(halo + ((size_t)(row >> 4) * 3 + (fr - 13)) * GCONV + col0 + bj * 128) = w;
                    }
                } else if (wc == 0) {
                    *(f32x4*)(ba + (size_t)row * 32 + 8 * fq) = acc[ai][0][m][0] * rstd;
                    *(f32x4*)(ba + (size_t)row * 32 + 8 * fq + 4) = acc[ai][0][m][1] * rstd;
                }
            }
    }
};

struct Args {
    const float* x; const float* norm_w; const float* ffn_w_in; const float* ffn_w_out; const float* attn_w_in; const float* attn_w_out;
    const float* gdn_w_in; const float* gdn_conv_w; const float* gdn_a_log; const float* gdn_dt_bias; const float* gdn_norm_w; const float* gdn_w_out; const float* final_norm_w;
    float* out; unsigned char* ws; int ph_lo, ph_hi;
};

__device__ __forceinline__ float wave_sum(float v) {
#pragma unroll
    for (int o = 1; o < 64; o <<= 1) v += __shfl_xor(v, o);
    return v;
}
__device__ __forceinline__ float wave_max(float v) {
#pragma unroll
    for (int o = 1; o < 64; o <<= 1) v = fmaxf(v, __shfl_xor(v, o));
    return v;
}

enum { MAP_ID = 0, MAP_FFNIN = 1, MAP_ATTNIN = 2, MAP_GDNIN = 3 };
template <int MAP> __device__ __forceinline__ int srcmap(int n, float& rs) {
    rs = 1.0f;
    if (MAP == MAP_ID) return n;
    if (MAP == MAP_FFNIN) { const int t = n >> 8, c = n & 255; return (c < 128) ? t * 128 + c : DFF + t * 128 + (c - 128); }
    if (MAP == MAP_ATTNIN) { const int sec = n / AW, r = n - sec * AW, hh = r >> 7, p = r & 127;
        const int e = (sec < 2) ? (64 * ((p >> 2) & 1) + 16 * (p >> 5) + 4 * ((p >> 3) & 3) + (p & 3)) : p;
        if (sec == 0) rs = 0.08838834764831845f;
        return sec * AW + hh * 128 + e; }
      return (n < NGSRC) ? n : -1;
}
template <int MAP> __device__ __forceinline__ void convert_matrix(const float* W, int K, int Nsrc, int Nd, bf16_t* WT, const float* nw, int gw, int NGW, LAS float* scr, int lane) {
    const int nblk = Nd / 32, nitems = (K / 64) * nblk;
    for (int item = gw; item < nitems; item += NGW) {
        const int kb = item / nblk, nb = item - kb * nblk, k0 = 64 * kb, n0 = 32 * nb;
        float rs; const int sc = srcmap<MAP>(n0 + (lane & 31), rs);
#pragma unroll 8
        for (int i = 0; i < 32; ++i) { const int kk = 2 * i + (lane >> 5);
            float v = 0.f; if (sc >= 0) { v = W[(size_t)(k0 + kk) * Nsrc + sc] * rs; if (nw) v *= nw[k0 + kk]; }
            scr[kk * 33 + (lane & 31)] = v; }
        __builtin_amdgcn_fence(__ATOMIC_RELEASE, "wavefront"); __builtin_amdgcn_wave_barrier(); __builtin_amdgcn_fence(__ATOMIC_ACQUIRE, "wavefront");
        const int c = lane & 7;
#pragma unroll
        for (int j = 0; j < 4; ++j) { const int n = (lane >> 3) + 8 * j; const LAS float* s = scr + (8 * c) * 33 + n;
            u32x4 o; o.x = pk2(s[0 * 33], s[1 * 33]); o.y = pk2(s[2 * 33], s[3 * 33]); o.z = pk2(s[4 * 33], s[5 * 33]); o.w = pk2(s[6 * 33], s[7 * 33]);
            *(u32x4*)(WT + (size_t)(n0 + n) * K + k0 + 8 * c) = o; }
        __builtin_amdgcn_fence(__ATOMIC_RELEASE, "wavefront"); __builtin_amdgcn_wave_barrier(); __builtin_amdgcn_fence(__ATOMIC_ACQUIRE, "wavefront");
    }
}


__device__ __forceinline__ int srcmap_rt(int map, int n, float& rs) {
    rs = 1.0f;
    if (map == MAP_ID) return n;
    if (map == MAP_FFNIN) { const int t = n >> 8, c = n & 255; return (c < 128) ? t * 128 + c : DFF + t * 128 + (c - 128); }
    if (map == MAP_ATTNIN) { const int sec = n / AW, r = n - sec * AW, hh = r >> 7, p = r & 127;
        const int e = (sec < 2) ? (64 * ((p >> 2) & 1) + 16 * (p >> 5) + 4 * ((p >> 3) & 3) + (p & 3)) : p;
        if (sec == 0) rs = 0.08838834764831845f;
        return sec * AW + hh * 128 + e; }
    return (n < NGSRC) ? n : -1;
}
constexpr int CV_PITCH = 67;
constexpr int CV_N0 = 8 * (DM / 64) * (NFF / 64), CV_N1 = CV_N0 + 8 * (DFF / 64) * (DM / 64), CV_N2 = CV_N1 + 2 * (DM / 64) * (NA / 64), CV_N3 = CV_N2 + 2 * (AW / 64) * (DM / 64),
              CV_N4 = CV_N3 + 2 * (DM / 64) * (NGP / 64), CV_N5 = CV_N4 + 2 * (GVD / 64) * (DM / 64);
__device__ __forceinline__ void convert_all(const Args& a, int gw, int NGW, LAS float* scr, int lane) {
    bf16_t* Wb = (bf16_t*)(a.ws + WS_W);
#pragma unroll 1
    for (int item = gw; item < CV_N5; item += NGW) {
        const float* W; bf16_t* WT; const float* nw = nullptr; int K, Nsrc, Nd, map, local;
        if (item < CV_N0) { const int per = (DM / 64) * (NFF / 64), idx = item / per; local = item - idx * per;
            W = a.ffn_w_in + (size_t)idx * DM * NFF; WT = Wb + W_FFNIN + (size_t)idx * SZ_FFNIN; nw = a.norm_w + (size_t)((idx >> 1) * 3 + 2 * (idx & 1)) * DM; K = DM; Nsrc = NFF; Nd = NFF; map = MAP_FFNIN; }
        else if (item < CV_N1) { const int r = item - CV_N0, per = (DFF / 64) * (DM / 64), idx = r / per; local = r - idx * per;
            W = a.ffn_w_out + (size_t)idx * DFF * DM; WT = Wb + W_FFNOUT + (size_t)idx * SZ_FFNOUT; K = DFF; Nsrc = DM; Nd = DM; map = MAP_ID; }
        else if (item < CV_N2) { const int r = item - CV_N1, per = (DM / 64) * (NA / 64), idx = r / per; local = r - idx * per;
            W = a.attn_w_in + (size_t)idx * DM * NA; WT = Wb + W_ATTNIN + (size_t)idx * SZ_ATTNIN; nw = a.norm_w + (size_t)((2 * idx) * 3 + 1) * DM; K = DM; Nsrc = NA; Nd = NA; map = MAP_ATTNIN; }
        else if (item < CV_N3) { const int r = item - CV_N2, per = (AW / 64) * (DM / 64), idx = r / per; local = r - idx * per;
            W = a.attn_w_out + (size_t)idx * AW * DM; WT = Wb + W_ATTNOUT + (size_t)idx * SZ_ATTNOUT; K = AW; Nsrc = DM; Nd = DM; map = MAP_ID; }
        else if (item < CV_N4) { const int r = item - CV_N3, per = (DM / 64) * (NGP / 64), idx = r / per; local = r - idx * per;
            W = a.gdn_w_in + (size_t)idx * DM * NGSRC; WT = Wb + W_GDNIN + (size_t)idx * SZ_GDNIN; nw = a.norm_w + (size_t)((2 * idx + 1) * 3 + 1) * DM; K = DM; Nsrc = NGSRC; Nd = NGP; map = MAP_GDNIN; }
        else { const int r = item - CV_N4, per = (GVD / 64) * (DM / 64), idx = r / per; local = r - idx * per;
            W = a.gdn_w_out + (size_t)idx * GVD * DM; WT = Wb + W_GDNOUT + (size_t)idx * SZ_GDNOUT; K = GVD; Nsrc = DM; Nd = DM; map = MAP_ID; }
        const int nblk = Nd >> 6, kb = local / nblk, nb = local - kb * nblk, k0 = 64 * kb, n0 = 64 * nb;
        const int nq = lane & 15, kr = lane >> 4;
        float rs; const int sc = srcmap_rt(map, n0 + 4 * nq, rs);
        f32x4 v[16];
#pragma unroll
        for (int i = 0; i < 16; ++i) v[i] = (sc >= 0) ? *(const f32x4*)(W + (size_t)(k0 + 4 * i + kr) * Nsrc + sc) : (f32x4){0.f, 0.f, 0.f, 0.f};
#pragma unroll
        for (int i = 0; i < 16; ++i) { const int kk = 4 * i + kr; const float s = nw ? rs * nw[k0 + kk] : rs; LAS float* d = scr + kk * CV_PITCH + 4 * nq;
            d[0] = v[i][0] * s; d[1] = v[i][1] * s; d[2] = v[i][2] * s; d[3] = v[i][3] * s; }
        __builtin_amdgcn_fence(__ATOMIC_RELEASE, "wavefront"); __builtin_amdgcn_wave_barrier(); __builtin_amdgcn_fence(__ATOMIC_ACQUIRE, "wavefront");
        const int c = lane & 7;
#pragma unroll
        for (int o = 0; o < 8; ++o) { const int n = (lane >> 3) + 8 * o; const LAS float* s = scr + (8 * c) * CV_PITCH + n;
            u32x4 w; w.x = pk2(s[0 * CV_PITCH], s[1 * CV_PITCH]); w.y = pk2(s[2 * CV_PITCH], s[3 * CV_PITCH]); w.z = pk2(s[4 * CV_PITCH], s[5 * CV_PITCH]); w.w = pk2(s[6 * CV_PITCH], s[7 * CV_PITCH]);
            *(u32x4*)(WT + (size_t)(n0 + n) * K + k0 + 8 * c) = w; }
        __builtin_amdgcn_fence(__ATOMIC_RELEASE, "wavefront"); __builtin_amdgcn_wave_barrier(); __builtin_amdgcn_fence(__ATOMIC_ACQUIRE, "wavefront");
    }
}

__device__ __forceinline__ void phase_prep(const Args& a, LAS unsigned char* lds, int G, int bid, int wave_sgpr) {
    int tid_ = (wave_sgpr * 64 + (int)__builtin_amdgcn_mbcnt_hi(~0u, __builtin_amdgcn_mbcnt_lo(~0u, 0u))); asm volatile("" : "+v"(tid_)); const int tid = tid_, lane = tid & 63, wave = __builtin_amdgcn_readfirstlane(tid >> 6);
    const int gw = bid * NWAVES + wave, NGW = G * NWAVES;
    LAS float* scr = (LAS float*)(lds + wave * (64 * CV_PITCH * 4));
    convert_all(a, gw, NGW, scr, lane);
    u64* ssq = (u64*)(a.ws + WS_SSQ); bf16_t* xb = (bf16_t*)(a.ws + WS_XB);
    for (int m = gw; m < MTOK; m += NGW) {
        const f32x4* xr = (const f32x4*)(a.x + (size_t)m * DM) + lane; u32x2* o8 = (u32x2*)(xb + (size_t)m * DM) + lane; float s = 0.f;
#pragma unroll
        for (int j = 0; j < 4; ++j) { const f32x4 v = xr[64 * j]; s += (v[0] * v[0] + v[1] * v[1]) + (v[2] * v[2] + v[3] * v[3]); u32x2 w; w.x = pk2(v[0], v[1]); w.y = pk2(v[2], v[3]); o8[64 * j] = w; }
        s = wave_sum(s); if (lane == 0) ssq[m] = (u64)(s * 1048576.0f);
    }
    for (size_t i = (size_t)bid * NTHREADS + tid; i < (size_t)12 * MTOK; i += (size_t)G * NTHREADS) ssq[MTOK + i] = 0ull;
    float* rope = (float*)(a.ws + WS_ROPE);
    for (int i = bid * NTHREADS + tid; i < SEQ * 64; i += G * NTHREADS) {
        const int pos = i >> 6, j = i & 63;
        const float inv = 1.0f / powf(10000.0f, (float)(2 * j) * (1.0f / 128.0f));
        const float ang = (float)pos * inv;
        const double ad = (double)ang; const double n = rint(ad * 0.15915494309189535); const float r = (float)(ad - n * 6.283185307179586);
        rope[i] = __cosf(r); rope[SEQ * 64 + i] = __sinf(r);
    }
}


constexpr int ATT_UNITS = NB * 3 * 4 * 32, ATT_KP = 272, ATT_VP = 288  , ATT_VT_OFF = 256 * ATT_KP;
static_assert(ATT_VT_OFF + 256 * ATT_VP <= LDS_BYTES - 8, "attention lds");
struct AttUnit { int d, head, i0; size_t tokbase; };
__device__ __forceinline__ AttUnit att_decode(int u) {
    const int blk32 = u & 31, hq = (u >> 5) & 3, gq = u >> 7, g = gq % 3, b = gq / 3, dsh = 2 * g, nblk = 32 >> dsh, r = blk32 / nblk, ib = blk32 - r * nblk;
    AttUnit U; U.d = 1 << dsh; U.head = g * 4 + hq; U.i0 = ib * 128; U.tokbase = (size_t)b * SEQ + r; return U;
}
__device__ __forceinline__ void att_issue(const bf16_t* qkv, int u, int tid, int wave, int l15, int lq, u32x4 (&kreg)[8], u32x4 (&vreg)[8], u32x4 (&qn)[4]) {
    const AttUnit U = att_decode(u);
    const u32x4 zero = {0u, 0u, 0u, 0u};
    asm volatile("" : "+v"(tid));
#pragma unroll
    for (int i = 0; i < 8; ++i) { const int idx = U.i0 - 128 + (tid >> 4) + 32 * i;
        kreg[i] = (idx >= 0) ? *(const u32x4*)(qkv + (U.tokbase + (size_t)idx * U.d) * NA + AW + U.head * 128 + (tid & 15) * 8) : zero; }
#pragma unroll
    for (int i = 0; i < 8; ++i) { const int idx = U.i0 - 128 + (tid >> 4) + 32 * i;
        vreg[i] = (idx >= 0) ? *(const u32x4*)(qkv + (U.tokbase + (size_t)idx * U.d) * NA + 2 * AW + U.head * 128 + (tid & 15) * 8) : zero; }
    const size_t qtok = U.tokbase + (size_t)(U.i0 + 16 * wave + l15) * U.d;
#pragma unroll
    for (int es = 0; es < 4; ++es) qn[es] = *(const u32x4*)(qkv + qtok * NA + U.head * 128 + es * 32 + 8 * lq);
}
__device__ __forceinline__ void phase_attn(const Args& a, LAS unsigned char* lds, int G, int bid, int wave_sgpr) {
    int tid_ = (wave_sgpr * 64 + (int)__builtin_amdgcn_mbcnt_hi(~0u, __builtin_amdgcn_mbcnt_lo(~0u, 0u))); asm volatile("" : "+v"(tid_)); const int tid = tid_, lane = tid & 63, wave = __builtin_amdgcn_readfirstlane(tid >> 6);
    const int l15 = lane & 15, lq = lane >> 4, kb0 = 2 * (wave >> 1);
    const bf16_t* qkv = (const bf16_t*)(a.ws + WS_BIG); bf16_t* ao = (bf16_t*)(a.ws + WS_AO); float* lse = (float*)(a.ws + WS_BA);
    LAS unsigned char* Ks = lds; LAS unsigned char* Vt = lds + ATT_VT_OFF;
    u32x4 kreg[8], vreg[8], qn[4];
    int u = ((G & 7) == 0) ? (bid & 7) * (G >> 3) + (bid >> 3) : bid;
    if (u < ATT_UNITS) att_issue(qkv, u, tid, wave, l15, lq, kreg, vreg, qn);
    for (; u < ATT_UNITS; u += G) {
        const AttUnit U = att_decode(u);
#pragma unroll
        for (int i = 0; i < 8; ++i) *(LAS u32x4*)(Ks + ((tid >> 4) + 32 * i) * ATT_KP + (tid & 15) * 16) = kreg[i];
#pragma unroll
        for (int i = 0; i < 8; ++i) *(LAS u32x4*)(Vt + ((tid >> 4) + 32 * i) * ATT_VP + (tid & 15) * 16) = vreg[i];
        bf16x8 qf[4];
#pragma unroll
        for (int es = 0; es < 4; ++es) qf[es] = __builtin_bit_cast(bf16x8, qn[es]);
        __syncthreads();
        if (u + G < ATT_UNITS) att_issue(qkv, u + G, tid, wave, l15, lq, kreg, vreg, qn);
        f32x4 S[10];
#pragma unroll
        for (int kk = 0; kk < 10; ++kk) { f32x4 acc = {0.f, 0.f, 0.f, 0.f}; const LAS unsigned char* kp = Ks + ((kb0 + kk) * 16 + l15) * ATT_KP + lq * 16;
#pragma unroll
            for (int es = 0; es < 4; ++es) acc = __builtin_amdgcn_mfma_f32_16x16x32_bf16(*(const LAS bf16x8*)(kp + es * 64), qf[es], acc, 0, 0, 0);
            S[kk] = acc; }
        const int qi = 16 * wave + l15, lo = (U.i0 == 0) ? 128 : qi, hi = qi + 128;
        float mx = -INFINITY;
#pragma unroll
        for (int kk = 0; kk < 10; ++kk)
#pragma unroll
            for (int j = 0; j < 4; ++j) { const int kj = 16 * (kb0 + kk) + 4 * lq + j; const float s = (kj >= lo && kj <= hi) ? S[kk][j] : -INFINITY; S[kk][j] = s; mx = fmaxf(mx, s); }
        mx = fmaxf(mx, __shfl_xor(mx, 16)); mx = fmaxf(mx, __shfl_xor(mx, 32));
        float den = 0.f;
#pragma unroll
        for (int kk = 0; kk < 10; ++kk)
#pragma unroll
            for (int j = 0; j < 4; ++j) { const float p = fexp(S[kk][j] - mx); S[kk][j] = p; den += p; }
        den += __shfl_xor(den, 16); den += __shfl_xor(den, 32);
        f32x4 O[8];
#pragma unroll
        for (int dvb = 0; dvb < 8; ++dvb) O[dvb] = (f32x4){0.f, 0.f, 0.f, 0.f};
#pragma unroll
        for (int sp = 0; sp < 5; ++sp) {
            u32x4 pw; pw.x = pk2(S[2 * sp][0], S[2 * sp][1]); pw.y = pk2(S[2 * sp][2], S[2 * sp][3]); pw.z = pk2(S[2 * sp + 1][0], S[2 * sp + 1][1]); pw.w = pk2(S[2 * sp + 1][2], S[2 * sp + 1][3]);
            const bf16x8 pf = __builtin_bit_cast(bf16x8, pw);
            const unsigned va = (unsigned)(size_t)(Vt + (32 * ((kb0 >> 1) + sp) + 4 * lq + (l15 >> 2)) * ATT_VP + (l15 & 3) * 8);
#pragma unroll
            for (int hb = 0; hb < 2; ++hb) {
                u32x2 t0[4], t1[4];
                const unsigned vb = va + hb * 128;
                asm volatile(
                    "ds_read_b64_tr_b16 %0, %8 offset:0\n\tds_read_b64_tr_b16 %1, %8 offset:32\n\tds_read_b64_tr_b16 %2, %8 offset:64\n\tds_read_b64_tr_b16 %3, %8 offset:96\n\t"
                    "ds_read_b64_tr_b16 %4, %8 offset:4608\n\tds_read_b64_tr_b16 %5, %8 offset:4640\n\tds_read_b64_tr_b16 %6, %8 offset:4672\n\tds_read_b64_tr_b16 %7, %8 offset:4704\n\t"
                    "s_waitcnt lgkmcnt(0)"
                    : "=&v"(t0[0]), "=&v"(t0[1]), "=&v"(t0[2]), "=&v"(t0[3]), "=&v"(t1[0]), "=&v"(t1[1]), "=&v"(t1[2]), "=&v"(t1[3])
                    : "v"(vb) : "memory");
#pragma unroll
                for (int d4 = 0; d4 < 4; ++d4) { const int dvb = 4 * hb + d4; u32x4 vw; vw.x = t0[d4].x; vw.y = t0[d4].y; vw.z = t1[d4].x; vw.w = t1[d4].y;
                    O[dvb] = __builtin_amdgcn_mfma_f32_16x16x32_bf16(__builtin_bit_cast(bf16x8, vw), pf, O[dvb], 0, 0, 0); }
            }
        }
        const float rden = 1.0f / den; const size_t tok = U.tokbase + (size_t)(U.i0 + qi) * U.d;
#pragma unroll
        for (int dvb = 0; dvb < 8; ++dvb) { u32x2 w; w.x = pk2(O[dvb][0] * rden, O[dvb][1] * rden); w.y = pk2(O[dvb][2] * rden, O[dvb][3] * rden);
            *(u32x2*)(ao + tok * AW + U.head * 128 + dvb * 16 + 4 * lq) = w; }
        if (lq == 0) lse[tok * 12 + U.head] = mx + __logf(den);
        __syncthreads();
    }
}
__device__ __forceinline__ void phase_attn_combine(const Args& a, int G, int bid, bool dry, int wave_sgpr) {
    int tid_ = (wave_sgpr * 64 + (int)__builtin_amdgcn_mbcnt_hi(~0u, __builtin_amdgcn_mbcnt_lo(~0u, 0u))); asm volatile("" : "+v"(tid_)); const int tid = tid_, lane = tid & 63, wave = __builtin_amdgcn_readfirstlane(tid >> 6);
    const int gw = bid * NWAVES + wave, NGW = G * NWAVES, hq = lane >> 4;
    bf16_t* ao = (bf16_t*)(a.ws + WS_AO); const float* lse = (const float*)(a.ws + WS_BA);
    for (int m = gw; m < MTOK; m += NGW) {
        const float l0 = lse[(size_t)m * 12 + hq], l1 = lse[(size_t)m * 12 + 4 + hq], l2 = lse[(size_t)m * 12 + 8 + hq];
        const float lm = fmaxf(l0, fmaxf(l1, l2)); const float e0 = fexp(l0 - lm), e1 = fexp(l1 - lm), e2 = fexp(l2 - lm), rs = 1.0f / (e0 + e1 + e2);
        const float al[3] = {e0 * rs, e1 * rs, e2 * rs};
#pragma unroll
        for (int i = 0; i < 3; ++i) { u32x4* p = (u32x4*)(ao + (size_t)m * AW + (lane + 64 * i) * 8); const u32x4 w = *p; const float s = al[i]; u32x4 o;
            o.x = pk2(bf_lo(w.x) * s, bf_hi(w.x) * s); o.y = pk2(bf_lo(w.y) * s, bf_hi(w.y) * s); o.z = pk2(bf_lo(w.z) * s, bf_hi(w.z) * s); o.w = pk2(bf_lo(w.w) * s, bf_hi(w.w) * s); if (!dry) *p = o; }
    }
}


constexpr int GD_P = 272, GD_KTP = 136, GD_QKP = 144, GD_OTP = 132;
constexpr int GD_QN = 0, GD_KN = 17408, GD_VS = 34816, GD_KT = 52224, GD_ST = 69632, GD_GATE = 104448, GD_CW = 105728, GD_RAW = 111872;
constexpr int GD_QKD = GD_RAW, GD_LM = GD_RAW + 9216, GD_OT = GD_RAW + 9216;
constexpr int GD_LB = GD_RAW + 25600, GD_LBP = 136, GD_TDR = GD_LB + 64 * GD_LBP, GD_TDC = GD_TDR + 2048;
static_assert(GD_TDC + 2048 <= GD_RAW + 3 * 67 * 256, "gdn lds map 2");
typedef short bf16x4 __attribute__((ext_vector_type(4)));
__device__ __forceinline__ bf16x4 pack4(f32x4 v) { u32x2 w; w.x = pk2(v[0], v[1]); w.y = pk2(v[2], v[3]); return __builtin_bit_cast(bf16x4, w); }
static_assert(GD_RAW + 3 * 67 * 256 <= LDS_BYTES && GD_OT + 64 * GD_OTP * 4 <= GD_RAW + 3 * 67 * 256, "gdn lds map");
#define LAUNDER(p) asm volatile("" : "+v"(p))
template <int CTRL> __device__ __forceinline__ float dpp_mov(float v) { return __builtin_bit_cast(float, __builtin_amdgcn_update_dpp(0, __builtin_bit_cast(int, v), CTRL, 0xf, 0xf, false)); }
__device__ __forceinline__ float row_sum16(float v) {
    v += dpp_mov<0x128>(v); v += dpp_mov<0x124>(v); v += dpp_mov<0x122>(v); v += dpp_mov<0x121>(v); return v; }
#define XB_TMO      128
#define XB_XCNT(j)  (256  + 64 * (j))
#define XB_XSUB(j)  (1280 + 64 * (j))
#define XB_XGEN(j)  (2304 + 64 * (j))
#define XB_TOP      3328
#define XB_TOPGEN   3392
#define XCD_BAR_WORDS 3456
#define XB_SPIN_CAP (1u << 18)

__device__ __forceinline__ unsigned xb_ld(unsigned* p)              { return __hip_atomic_load(p, __ATOMIC_RELAXED, __HIP_MEMORY_SCOPE_AGENT); }
__device__ __forceinline__ unsigned xb_add(unsigned* p, unsigned v) { return __hip_atomic_fetch_add(p, v, __ATOMIC_RELAXED, __HIP_MEMORY_SCOPE_AGENT); }
__device__ __forceinline__ unsigned xb_xcc_id() { return (unsigned)__builtin_amdgcn_s_getreg((3 << 11) | 20) & 0xFu; }
#define XB_SPIN(cond, bar) do { unsigned _sp = 0; while (cond) { __builtin_amdgcn_s_sleep(1); \
    if ((++_sp & 255u) == 0u) { if (xb_ld(&(bar)[XB_TMO])) break; if (_sp > XB_SPIN_CAP) { atomicAdd(&(bar)[XB_TMO], 1u); break; } } } } while (0)

struct XcdBarrier {
    unsigned* bar; unsigned x;
    volatile LAS unsigned* st;
};

__device__ __forceinline__ XcdBarrier xcd_barrier_post(unsigned* bar, volatile LAS unsigned* st, bool is_t0) {
    XcdBarrier b; b.bar = bar; b.x = xb_xcc_id(); b.st = st;
    if (is_t0) (void)xb_add(&bar[XB_XCNT(b.x)], 1u);
    return b;
}
__device__ __forceinline__ void xcd_barrier_complete(unsigned* bar, unsigned x, unsigned& nloc, unsigned& nx) {
    const unsigned G = gridDim.x * gridDim.y * gridDim.z;
    unsigned sum, cnt, mine, sp = 0u;
    for (;;) {
        sum = 0u; cnt = 0u; mine = 0u;
#pragma unroll
        for (unsigned j = 0; j < 16; ++j) { const unsigned c = xb_ld(&bar[XB_XCNT(j)]); sum += c; cnt += (c > 0u) ? 1u : 0u; mine = (j == x) ? c : mine; }
        if (sum == G) break;
        __builtin_amdgcn_s_sleep(1);
        if ((++sp & 255u) == 0u) { if (xb_ld(&bar[XB_TMO])) break; if (sp > XB_SPIN_CAP) { atomicAdd(&bar[XB_TMO], 1u); break; } }
    }
    nloc = mine > 0u ? mine : 1u; nx = cnt > 0u ? cnt : 1u;
}

__device__ __forceinline__ void xcd_barrier(const XcdBarrier& b, bool is_t0) {
    asm volatile("s_waitcnt vmcnt(0)" ::: "memory");
    __syncthreads();
    if (is_t0) {
        unsigned* bar = b.bar;
        __builtin_amdgcn_s_waitcnt(0);
        unsigned nloc = b.st[0], nx = b.st[1];
        if (nloc == 0u) { xcd_barrier_complete(bar, b.x, nloc, nx); b.st[0] = nloc; b.st[1] = nx; }
        const unsigned old = xb_add(&bar[XB_XSUB(b.x)], 1u);
        const unsigned gen = old / nloc;
        if (old + 1u == (gen + 1u) * nloc) {
            __builtin_amdgcn_fence(__ATOMIC_RELEASE, "agent");
            asm volatile("s_waitcnt vmcnt(0)" ::: "memory");
            const unsigned og = xb_add(&bar[XB_TOP], 1u);
            const unsigned tg = og / nx;
            if (og + 1u == (tg + 1u) * nx) xb_add(&bar[XB_TOPGEN], 1u);
            else XB_SPIN(xb_ld(&bar[XB_TOPGEN]) == tg, bar);
            __builtin_amdgcn_fence(__ATOMIC_ACQUIRE, "agent");
            xb_add(&bar[XB_XGEN(b.x)], 1u);
            asm volatile("s_waitcnt vmcnt(0)" ::: "memory");
        } else {
            XB_SPIN(xb_ld(&bar[XB_XGEN(b.x)]) == gen, bar);
            __builtin_amdgcn_fence(__ATOMIC_ACQUIRE, "agent");
            asm volatile("s_waitcnt vmcnt(0)" ::: "memory");
        }
    }
    __syncthreads();
}


__device__ __forceinline__ void phase_gdn_pre(const Args& a, int ib_, int wave_sgpr, int s_lo, int nseg, int wg0, int nwg) {
    const int bid = blockIdx.x - wg0, G = nwg;
    int tid_ = (wave_sgpr * 64 + (int)__builtin_amdgcn_mbcnt_hi(~0u, __builtin_amdgcn_mbcnt_lo(~0u, 0u))); asm volatile("" : "+v"(tid_)); const int tid = tid_, lane = tid & 63, wave = __builtin_amdgcn_readfirstlane(tid >> 6);
    const int gw = bid * NWAVES + wave, NGW = G * NWAVES, k = lane >> 4, grp = lane & 15;
    bf16_t* proj = (bf16_t*)(a.ws + WS_BIG); float* ba = (float*)(a.ws + WS_BA); const bf16_t* halo = (const bf16_t*)a.out;
    const float* cw = a.gdn_conv_w + (size_t)ib_ * 4 * GCONV;
#pragma unroll 1
    for (int item = gw; item < NB * nseg * 32; item += NGW) {
        const int h = item & 31, sq_ = item >> 5, bb_ = sq_ / nseg, seg = bb_ * 64 + s_lo + (sq_ - bb_ * nseg);
        const int type = (h < 8) ? 0 : (h < 16 ? 1 : 2), hv = h - 16;
        const int col = ((h < 8) ? h * 128 : (h < 16 ? GKD + (h - 8) * 128 : 2 * GKD + hv * 128)) + grp * 8;
        float aexp = 0.f, dtb = 0.f; if (type == 2) { aexp = fexp(a.gdn_a_log[ib_ * 16 + hv]); dtb = a.gdn_dt_bias[ib_ * 16 + hv]; }
        const size_t mrow0 = (size_t)seg * 64 + 16 * k; const int run = (int)(mrow0 >> 4);
        bf16_t* p = proj + mrow0 * PPITCH + col;
        u32x4 rows[19];
#pragma unroll
        for (int j = 0; j < 3; ++j) rows[j] = ((mrow0 & (SEQ - 1)) != 0) ? *(const u32x4*)(halo + ((size_t)(run - 1) * 3 + j) * GCONV + col) : (u32x4){0u, 0u, 0u, 0u};
#pragma unroll
        for (int s = 0; s < 16; ++s) rows[3 + s] = *(const u32x4*)(p + (size_t)s * PPITCH);
        f32x4 wgt[4][2];
#pragma unroll
        for (int j = 0; j < 4; ++j) { wgt[j][0] = *(const f32x4*)(cw + (size_t)j * GCONV + col); wgt[j][1] = *(const f32x4*)(cw + (size_t)j * GCONV + col + 4); }
        float bl[16], al[16];
        if (type == 2 && grp == 0) {
#pragma unroll
            for (int s = 0; s < 16; ++s) { bl[s] = ba[(mrow0 + s) * 32 + hv]; al[s] = ba[(mrow0 + s) * 32 + 16 + hv]; }
        }
#define UNPK8(dst, v) do { dst[0] = bf_lo(v.x); dst[1] = bf_hi(v.x); dst[2] = bf_lo(v.y); dst[3] = bf_hi(v.y); dst[4] = bf_lo(v.z); dst[5] = bf_hi(v.z); dst[6] = bf_lo(v.w); dst[7] = bf_hi(v.w); } while (0)
        float w3[8], w2[8], w1[8];
        UNPK8(w3, rows[0]); UNPK8(w2, rows[1]); UNPK8(w1, rows[2]);
#pragma unroll
        for (int s = 0; s < 16; ++s) {
            float w0[8]; UNPK8(w0, rows[3 + s]);
            float y[8], ss = 0.f;
#pragma unroll
            for (int q = 0; q < 8; ++q) { const float v = wgt[0][q >> 2][q & 3] * w3[q] + wgt[1][q >> 2][q & 3] * w2[q] + wgt[2][q >> 2][q & 3] * w1[q] + wgt[3][q >> 2][q & 3] * w0[q];
                y[q] = silu_f(v); ss += y[q] * y[q]; w3[q] = w2[q]; w2[q] = w1[q]; w1[q] = w0[q]; }
            float mul = 1.0f;
            if (type < 2) { ss = row_sum16(ss); mul = rsqrtf(ss + 1e-6f); if (type == 0) mul *= 0.08838834764831845f; }
            u32x4 o; o.x = pk2(y[0] * mul, y[1] * mul); o.y = pk2(y[2] * mul, y[3] * mul); o.z = pk2(y[4] * mul, y[5] * mul); o.w = pk2(y[6] * mul, y[7] * mul);
            *(u32x4*)(p + (size_t)s * PPITCH) = o;
        }
#undef UNPK8
        if (type == 2 && grp == 0) {
#pragma unroll
            for (int s = 0; s < 16; ++s) { const float x = al[s] + dtb; const float sp = (x > 20.f) ? x : log1pf(fexp(x));
                ba[(mrow0 + s) * 32 + hv] = 1.0f / (1.0f + fexp(-bl[s])); ba[(mrow0 + s) * 32 + 16 + hv] = -aexp * sp; }
        }
    }
}
__device__ __forceinline__ int perm_pos(int j) { return (j & ~31) + 8 * ((j & 15) >> 2) + 4 * ((j >> 4) & 1) + (j & 3); }
__device__ __forceinline__ float bf1(unsigned short h) { return __uint_as_float((unsigned)h << 16); }
__device__ __forceinline__ unsigned short f2bf(float f) { return (unsigned short)(pk2(f, 0.f) & 0xffffu); }

__device__ __forceinline__ void gdn_issue(const bf16_t* proj, const float* ba, int b, int hv, int c, int tid, u32x4 (&raw)[7], float& bl, float& al) {
    const u32x4 zero = {0u, 0u, 0u, 0u}; const int hk = hv >> 1;
    asm volatile("" : "+v"(tid));
#pragma unroll
    for (int i = 0; i < 7; ++i) {
        const int id = (tid - 64) + 448 * i; raw[i] = zero;
        if (id < 3072) { const int tens = id >> 10, cc = (id >> 6) & 15, row = id & 63;
            const int col = (tens == 0 ? hk * 128 : (tens == 1 ? GKD + hk * 128 : 2 * GKD + hv * 128)) + cc * 8;
            raw[i] = *(const u32x4*)(proj + (size_t)(b * SEQ + c * 64 + row) * PPITCH + col); }
    }
    bl = 0.f; al = 0.f;
    if (tid < 128) { const size_t m = (size_t)b * SEQ + c * 64 + (tid - 64); bl = ba[m * 32 + hv]; al = ba[m * 32 + 16 + hv]; }
}

__device__ __forceinline__ void phase_gdn(const Args& a, LAS unsigned char* lds, int G, int bid, int ib_, bool dry, int wave_sgpr, const XcdBarrier& xbar, bool is_t0, bool overlap) {
    int tid_ = (wave_sgpr * 64 + (int)__builtin_amdgcn_mbcnt_hi(~0u, __builtin_amdgcn_mbcnt_lo(~0u, 0u))); asm volatile("" : "+v"(tid_)); const int tid = tid_, lane = tid & 63, wave = __builtin_amdgcn_readfirstlane(tid >> 6);
    const int l15 = lane & 15, lq = lane >> 4;
    bf16_t* proj = (bf16_t*)(a.ws + WS_BIG); const float* ba = (const float*)(a.ws + WS_BA);
    const float* gnw = a.gdn_norm_w + ib_ * 128;
    LAS float* gate = (LAS float*)(lds + GD_GATE);
    LAS float* Lm = (LAS float*)(lds + GD_LM); LAS float* Ot = (LAS float*)(lds + GD_OT);
    for (int unit = bid; unit < NB * 16; unit += G) {
        const int b = unit >> 4, hv = unit & 15, hk = hv >> 1;
        for (int i = tid; i < 128 * GD_P / 4; i += NTHREADS) ((LAS unsigned*)(lds + GD_ST))[i] = 0u;
        f32x4 Sacc[8];
#pragma unroll
        for (int eb = 0; eb < 8; ++eb) Sacc[eb] = (f32x4){0.f, 0.f, 0.f, 0.f};
        u32x4 raw[7]; float bl = 0.f, al = 0.f;
#pragma unroll
        for (int i = 0; i < 7; ++i) raw[i] = (u32x4){0u, 0u, 0u, 0u};
        if (wave >= 1) gdn_issue(proj, ba, b, hv, 0, tid, raw, bl, al);
        { int tq = tid; asm volatile("" : "+v"(tq)); const int lane_c = tq & 63;
        const float bl_c = bl, al_c = al;
        if (wave >= 1) {
#pragma unroll
            for (int i = 0; i < 7; ++i) {
                const int id = (tq - 64) + 448 * i;
                if (id < 3072) { const int tens = id >> 10, cc = (id >> 6) & 15, row = id & 63; const u32x4 w = raw[i];
                    *(LAS u32x4*)(lds + (tens == 0 ? GD_QN : (tens == 1 ? GD_KN : GD_VS)) + row * GD_P + cc * 16) = w;
                }
            }
        }
        if (wave == 1) {
            const float beta = bl_c; float v = al_c;
#pragma unroll
            for (int off = 1; off < 64; off <<= 1) { const float t = __shfl_up(v, off); if (lane_c >= off) v += t; }
            const float g63 = __shfl(v, 63), eg = fexp(v);
            gate[lane_c] = beta; gate[64 + lane_c] = v; gate[128 + lane_c] = eg; gate[192 + lane_c] = fexp(g63 - v); gate[256 + lane_c] = beta * eg;
        }
        }
        __syncthreads();
        for (int c = 0; c < SEQ / 64; ++c) {
            if (overlap && c >= 15 && c < 63 && ((c - 15) & 7) == 0) xcd_barrier(xbar, is_t0);
            int tq = tid; asm volatile("" : "+v"(tq)); const int lane_c = tq & 63;
            {
                const int ib = wave & 3; const bool isq = wave >= 4;
                const LAS unsigned char* abase = lds + (isq ? GD_QN : GD_KN) + (16 * ib + l15) * GD_P + lq * 16; LAUNDER(abase);
                const LAS unsigned char* kbase = lds + GD_KN + l15 * GD_P + lq * 16; LAUNDER(kbase);
                const LAS float* gt = gate; LAUNDER(gt);
                LAS float* lmw = Lm + (16 * ib + 4 * lq) * 64 + l15; LAUNDER(lmw);
                LAS unsigned char* lbw = lds + GD_LB + (16 * ib + 4 * lq) * GD_LBP + l15 * 2; LAUNDER(lbw);
                LAS unsigned char* qkw = lds + GD_QKD + (16 * ib + 4 * lq) * GD_QKP + perm_pos(l15) * 2; LAUNDER(qkw);
                bf16x8 af[4];
#pragma unroll
                for (int es = 0; es < 4; ++es) af[es] = *(const LAS bf16x8*)(abase + es * 64);
                float gi[4], bi[4];
#pragma unroll
                for (int jj = 0; jj < 4; ++jj) { gi[jj] = gt[64 + 16 * ib + 4 * lq + jj]; bi[jj] = gt[16 * ib + 4 * lq + jj]; }
#pragma unroll
                for (int jb = 0; jb < 4; ++jb) {
                    const int j = 16 * jb + l15;
                    if (jb <= ib) {
                        f32x4 acc = {0.f, 0.f, 0.f, 0.f}; const LAS unsigned char* bbase = kbase + 16 * jb * GD_P;
#pragma unroll
                        for (int es = 0; es < 4; ++es) acc = __builtin_amdgcn_mfma_f32_16x16x32_bf16(af[es], *(const LAS bf16x8*)(bbase + es * 64), acc, 0, 0, 0);
                        const float gj = gt[64 + j];
#pragma unroll
                        for (int jj = 0; jj < 4; ++jj) { const int i = 16 * ib + 4 * lq + jj;
                            if (!isq) { const float v = (i > j) ? bi[jj] * acc[jj] * fexp(gi[jj] - gj) : 0.f; lmw[jj * 64 + 16 * jb] = v; *(LAS unsigned short*)(lbw + jj * GD_LBP + 32 * jb) = f2bf(v); }
                            else { const float v = (i >= j) ? acc[jj] * fexp(gi[jj] - gj) : 0.f; *(LAS unsigned short*)(qkw + jj * GD_QKP + (32 * (jb >> 1) + 4 * (jb & 1)) * 2) = f2bf(v); } }
                    } else if (isq) {
#pragma unroll
                        for (int jj = 0; jj < 4; ++jj) *(LAS unsigned short*)(qkw + jj * GD_QKP + (32 * (jb >> 1) + 4 * (jb & 1)) * 2) = 0;
                    }
                }
            }
            __syncthreads();
            if (wave == 0) {
                const int g = lane_c >> 4, cc = lane_c & 15;
                const LAS float* lmd = Lm + (16 * g) * 64 + 16 * g; LAUNDER(lmd);
                f32x2 X[8];
#pragma unroll
                for (int p = 0; p < 8; ++p) X[p] = (f32x2){0.f, 0.f};
#pragma unroll
                for (int r = 0; r < 16; ++r) {
                    const int nq = (r + 3) / 4;
                    f32x4 l4[4];
#pragma unroll
                    for (int q = 0; q < nq; ++q) l4[q] = *(const LAS f32x4*)(lmd + r * 64 + 4 * q);
                    f32x2 acc0 = {0.f, 0.f}, acc1 = {0.f, 0.f};
#pragma unroll
                    for (int q = 0; q < nq; ++q) {
                        acc0 += (f32x2){l4[q][0], l4[q][1]} * X[2 * q];
                        if (2 * q + 1 < (r + 1) / 2) acc1 += (f32x2){l4[q][2], l4[q][3]} * X[2 * q + 1];
                    }
                    const float x = ((cc == r) ? 1.0f : 0.0f) - ((acc0.x + acc0.y) + (acc1.x + acc1.y));
                    if (r & 1) X[r >> 1].y = x; else X[r >> 1].x = x;
                }
                LAS unsigned char* tdr = lds + GD_TDR + g * 512 + cc * 2; LAUNDER(tdr);
#pragma unroll
                for (int r = 0; r < 16; ++r) *(LAS unsigned short*)(tdr + r * 32) = f2bf((r & 1) ? X[r >> 1].y : X[r >> 1].x);
                u32x4 c0, c1;
                c0.x = pk2(X[0].x, X[0].y); c0.y = pk2(X[1].x, X[1].y); c0.z = pk2(X[2].x, X[2].y); c0.w = pk2(X[3].x, X[3].y);
                c1.x = pk2(X[4].x, X[4].y); c1.y = pk2(X[5].x, X[5].y); c1.z = pk2(X[6].x, X[6].y); c1.w = pk2(X[7].x, X[7].y);
                LAS unsigned char* tdc = lds + GD_TDC + g * 512 + cc * 32; LAUNDER(tdc);
                *(LAS u32x4*)tdc = c0; *(LAS u32x4*)(tdc + 16) = c1;
                __syncthreads();
                { const int c = lane_c; const float sb = gate[c], sw = gate[256 + c];
                  LAS unsigned char* tw = lds + GD_LM + (16 * g) * 128 + perm_pos(c) * 2; LAUNDER(tw);
#pragma unroll
                  for (int r = 0; r < 16; ++r) { const float x = (r & 1) ? X[r >> 1].y : X[r >> 1].x;
                      *(LAS unsigned short*)(tw + r * 128) = f2bf(x * sb); *(LAS unsigned short*)(tw + 8192 + r * 128) = f2bf(x * sw); } }
#pragma unroll
                for (int i = 0; i < 7; ++i) raw[i] = (u32x4){0u, 0u, 0u, 0u};
            } else {
                if (c + 1 < SEQ / 64) gdn_issue(proj, ba, b, hv, c + 1, tq, raw, bl, al);
                __syncthreads();
            }
            if (wave < 3) {
                const int c = 16 * wave + l15; const float sb = gate[c], sw = gate[256 + c];
                const LAS unsigned char* lbb = lds + GD_LB + l15 * GD_LBP + lq * 8; LAUNDER(lbb);
                const LAS unsigned char* tdb = lds + GD_TDR + l15 * 32 + lq * 8; LAUNDER(tdb);
                LAS unsigned char* tw = lds + GD_LM + (4 * lq) * 128 + perm_pos(c) * 2; LAUNDER(tw);
                bf16x4 Bop[4]; f32x4 Tb4[4];
#pragma unroll
                for (int i = 0; i < 4; ++i) { Bop[i] = (bf16x4){0, 0, 0, 0}; Tb4[i] = (f32x4){0.f, 0.f, 0.f, 0.f}; }
#pragma unroll
                for (int j = 0; j < 3; ++j) if (wave == j) {
                    Bop[j] = *(const LAS bf16x4*)(tdb + (GD_TDC - GD_TDR) + j * 512);
#pragma unroll
                    for (int i = j + 1; i < 4; ++i) {
                        f32x4 S = {0.f, 0.f, 0.f, 0.f};
#pragma unroll
                        for (int k = j; k < i; ++k) S = __builtin_amdgcn_mfma_f32_16x16x16bf16_1k(*(const LAS bf16x4*)(lbb + 16 * i * GD_LBP + 32 * k), Bop[k], S, 0, 0, 0);
                        const f32x4 Tn = __builtin_amdgcn_mfma_f32_16x16x16bf16_1k(*(const LAS bf16x4*)(tdb + i * 512), pack4(S), (f32x4){0.f, 0.f, 0.f, 0.f}, 0, 0, 0);
                        Tb4[i] = -Tn; Bop[i] = pack4(Tb4[i]);
#pragma unroll
                        for (int jj = 0; jj < 4; ++jj) { *(LAS unsigned short*)(tw + (16 * i + jj) * 128) = f2bf(Tb4[i][jj] * sb); *(LAS unsigned short*)(tw + 8192 + (16 * i + jj) * 128) = f2bf(Tb4[i][jj] * sw); }
                    }
                }
            } else if (wave == 3) {
                const int row = lane_c, ibz = row >> 4;
                for (int j = ibz + 1; j < 4; ++j)
#pragma unroll
                    for (int t = 0; t < 4; ++t) { LAS unsigned char* zp = lds + GD_LM + row * 128 + (32 * (j >> 1) + 8 * t + 4 * (j & 1)) * 2;
                        *(LAS u32x2*)zp = (u32x2){0u, 0u}; *(LAS u32x2*)(zp + 8192) = (u32x2){0u, 0u}; }
            }
            __syncthreads();
            u32x4 zreg[2];
#pragma unroll
            for (int i = 0; i < 2; ++i) zreg[i] = *(const u32x4*)(proj + (size_t)(b * SEQ + c * 64 + (tq >> 4) + 32 * i) * PPITCH + 2 * GKD + GVD + hv * 128 + (tq & 15) * 8);
            f32x4 vn[4];
            {
                const LAS unsigned char* tbb = lds + GD_LM + l15 * 128 + lq * 16; LAUNDER(tbb);
                LAS unsigned char* wmw = lds + GD_KT + l15 * GD_P + (16 * wave + 4 * lq) * 2; LAUNDER(wmw);
                bf16x8 kf[2], vf[2];
                {
                    const unsigned ka = (unsigned)(size_t)(lds + GD_KN + (4 * lq + (l15 >> 2)) * GD_P + (16 * wave + 4 * (l15 & 3)) * 2);
                    u32x2 r0, r1, r2, r3, r4, r5, r6, r7;
                    asm volatile("ds_read_b64_tr_b16 %0, %8 offset:0\n\tds_read_b64_tr_b16 %1, %8 offset:4352\n\tds_read_b64_tr_b16 %2, %8 offset:8704\n\tds_read_b64_tr_b16 %3, %8 offset:13056\n\t"
                                 "ds_read_b64_tr_b16 %4, %8 offset:17408\n\tds_read_b64_tr_b16 %5, %8 offset:21760\n\tds_read_b64_tr_b16 %6, %8 offset:26112\n\tds_read_b64_tr_b16 %7, %8 offset:30464\n\t"
                                 "s_waitcnt lgkmcnt(0)"
                                 : "=&v"(r0), "=&v"(r1), "=&v"(r2), "=&v"(r3), "=&v"(r4), "=&v"(r5), "=&v"(r6), "=&v"(r7) : "v"(ka) : "memory");
                    u32x4 w0; w0.x = r0.x; w0.y = r0.y; w0.z = r1.x; w0.w = r1.y; kf[0] = __builtin_bit_cast(bf16x8, w0);
                    u32x4 w1; w1.x = r2.x; w1.y = r2.y; w1.z = r3.x; w1.w = r3.y; kf[1] = __builtin_bit_cast(bf16x8, w1);
                    u32x4 w2; w2.x = r4.x; w2.y = r4.y; w2.z = r5.x; w2.w = r5.y; vf[0] = __builtin_bit_cast(bf16x8, w2);
                    u32x4 w3; w3.x = r6.x; w3.y = r6.y; w3.z = r7.x; w3.w = r7.y; vf[1] = __builtin_bit_cast(bf16x8, w3);
                }
#pragma unroll
                for (int ib = 0; ib < 4; ++ib) {
                    f32x4 wa = {0.f, 0.f, 0.f, 0.f}; vn[ib] = (f32x4){0.f, 0.f, 0.f, 0.f};
#pragma unroll
                    for (int s = 0; s < 2; ++s) {
                        wa = __builtin_amdgcn_mfma_f32_16x16x32_bf16(kf[s], *(const LAS bf16x8*)(tbb + 8192 + 16 * ib * 128 + 64 * s), wa, 0, 0, 0);
                        vn[ib] = __builtin_amdgcn_mfma_f32_16x16x32_bf16(*(const LAS bf16x8*)(tbb + 16 * ib * 128 + 64 * s), vf[s], vn[ib], 0, 0, 0);
                    }
                    u32x2 ww; ww.x = pk2(-wa[0], -wa[1]); ww.y = pk2(-wa[2], -wa[3]);
                    *(LAS u32x2*)(wmw + 16 * ib * GD_P) = ww;
                    __builtin_amdgcn_sched_barrier(0);
                }
            }
            __syncthreads();
            {
                const LAS unsigned char* stb = lds + GD_ST + (16 * wave + l15) * GD_P + lq * 16; LAUNDER(stb);
                const LAS unsigned char* wbb = lds + GD_KT + l15 * GD_P + lq * 16; LAUNDER(wbb);
                const LAS unsigned char* qbb = lds + GD_QN + l15 * GD_P + lq * 16; LAUNDER(qbb);
                const LAS float* gt = gate + 4 * lq; LAUNDER(gt);
                const LAS unsigned char* qkb = lds + GD_QKD + l15 * GD_QKP + lq * 16; LAUNDER(qkb);
                const unsigned kta = (unsigned)(size_t)(lds + GD_KN + (4 * lq + (l15 >> 2)) * GD_P + (4 * (l15 & 3)) * 2);
                LAS unsigned char* stw = lds + GD_ST + (16 * wave + l15) * GD_P + lq * 8; LAUNDER(stw);
                LAS float* otw = Ot + (4 * lq) * GD_OTP + 16 * wave + l15; LAUNDER(otw);
                bf16x8 sf[4];
#pragma unroll
                for (int es = 0; es < 4; ++es) sf[es] = *(const LAS bf16x8*)(stb + es * 64);
                f32x4 oa[4];
#pragma unroll
                for (int ib = 0; ib < 4; ++ib) {
                    oa[ib] = (f32x4){0.f, 0.f, 0.f, 0.f};
                    const LAS unsigned char* wb = wbb + 16 * ib * GD_P; const LAS unsigned char* qb = qbb + 16 * ib * GD_P;
#pragma unroll
                    for (int es = 0; es < 4; ++es) {
                        vn[ib] = __builtin_amdgcn_mfma_f32_16x16x32_bf16(*(const LAS bf16x8*)(wb + es * 64), sf[es], vn[ib], 0, 0, 0);
                        oa[ib] = __builtin_amdgcn_mfma_f32_16x16x32_bf16(*(const LAS bf16x8*)(qb + es * 64), sf[es], oa[ib], 0, 0, 0);
                    }
#pragma unroll
                    for (int jj = 0; jj < 4; ++jj) oa[ib][jj] *= gt[128 + 16 * ib + jj];
                    __builtin_amdgcn_sched_barrier(0);
                }
                bf16x8 bv[2], bvd[2];
#pragma unroll
                for (int s = 0; s < 2; ++s) {
                    u32x4 p, pd; float d0[4], d1[4];
#pragma unroll
                    for (int jj = 0; jj < 4; ++jj) { d0[jj] = gt[192 + 32 * s + jj]; d1[jj] = gt[192 + 32 * s + 16 + jj]; }
                    p.x = pk2(vn[2 * s][0], vn[2 * s][1]); p.y = pk2(vn[2 * s][2], vn[2 * s][3]); p.z = pk2(vn[2 * s + 1][0], vn[2 * s + 1][1]); p.w = pk2(vn[2 * s + 1][2], vn[2 * s + 1][3]);
                    pd.x = pk2(vn[2 * s][0] * d0[0], vn[2 * s][1] * d0[1]); pd.y = pk2(vn[2 * s][2] * d0[2], vn[2 * s][3] * d0[3]);
                    pd.z = pk2(vn[2 * s + 1][0] * d1[0], vn[2 * s + 1][1] * d1[1]); pd.w = pk2(vn[2 * s + 1][2] * d1[2], vn[2 * s + 1][3] * d1[3]);
                    bv[s] = __builtin_bit_cast(bf16x8, p); bvd[s] = __builtin_bit_cast(bf16x8, pd);
                }
#pragma unroll
                for (int ib = 0; ib < 4; ++ib)
#pragma unroll
                    for (int s = 0; s < 2; ++s)
                        oa[ib] = __builtin_amdgcn_mfma_f32_16x16x32_bf16(*(const LAS bf16x8*)(qkb + 16 * ib * GD_QKP + 64 * s), bv[s], oa[ib], 0, 0, 0);
                const float eg63 = gate[128 + 63];
#pragma unroll
                for (int eb = 0; eb < 8; ++eb) {
                    Sacc[eb] = Sacc[eb] * eg63;
                    { u32x2 r0, r1, r2, r3; const unsigned ke = kta + 32 * eb;
                      asm volatile("ds_read_b64_tr_b16 %0, %4 offset:0\n\tds_read_b64_tr_b16 %1, %4 offset:4352\n\tds_read_b64_tr_b16 %2, %4 offset:8704\n\tds_read_b64_tr_b16 %3, %4 offset:13056\n\ts_waitcnt lgkmcnt(0)"
                                   : "=&v"(r0), "=&v"(r1), "=&v"(r2), "=&v"(r3) : "v"(ke) : "memory");
                      u32x4 k0w; k0w.x = r0.x; k0w.y = r0.y; k0w.z = r1.x; k0w.w = r1.y; u32x4 k1w; k1w.x = r2.x; k1w.y = r2.y; k1w.z = r3.x; k1w.w = r3.y;
                      Sacc[eb] = __builtin_amdgcn_mfma_f32_16x16x32_bf16(__builtin_bit_cast(bf16x8, k0w), bvd[0], Sacc[eb], 0, 0, 0);
                      Sacc[eb] = __builtin_amdgcn_mfma_f32_16x16x32_bf16(__builtin_bit_cast(bf16x8, k1w), bvd[1], Sacc[eb], 0, 0, 0); }
                    u32x2 sw; sw.x = pk2(Sacc[eb][0], Sacc[eb][1]); sw.y = pk2(Sacc[eb][2], Sacc[eb][3]);
                    *(LAS u32x2*)(stw + 32 * eb) = sw;
                }
#pragma unroll
                for (int ib = 0; ib < 4; ++ib)
#pragma unroll
                    for (int jj = 0; jj < 4; ++jj) otw[(16 * ib + jj) * GD_OTP] = oa[ib][jj];
            }
            __syncthreads();
#pragma unroll
            for (int i = 0; i < 2; ++i) {
                const int tok = (tq >> 4) + 32 * i, grp = tq & 15;
                const f32x4 o0 = *(const LAS f32x4*)(Ot + tok * GD_OTP + grp * 8), o1 = *(const LAS f32x4*)(Ot + tok * GD_OTP + grp * 8 + 4);
                float ss = (o0[0] * o0[0] + o0[1] * o0[1]) + (o0[2] * o0[2] + o0[3] * o0[3]) + (o1[0] * o1[0] + o1[1] * o1[1]) + (o1[2] * o1[2] + o1[3] * o1[3]);
                ss = row_sum16(ss);
                const float rstd = rsqrtf(ss * (1.0f / 128.0f) + RMS_EPS);
                const u32x4 zw = zreg[i];
                const f32x4 w0 = *(const f32x4*)(gnw + grp * 8), w1 = *(const f32x4*)(gnw + grp * 8 + 4);
                u32x4 r;
                r.x = pk2(o0[0] * rstd * w0[0] * silu_f(bf_lo(zw.x)), o0[1] * rstd * w0[1] * silu_f(bf_hi(zw.x)));
                r.y = pk2(o0[2] * rstd * w0[2] * silu_f(bf_lo(zw.y)), o0[3] * rstd * w0[3] * silu_f(bf_hi(zw.y)));
                r.z = pk2(o1[0] * rstd * w1[0] * silu_f(bf_lo(zw.z)), o1[1] * rstd * w1[1] * silu_f(bf_hi(zw.z)));
                r.w = pk2(o1[2] * rstd * w1[2] * silu_f(bf_lo(zw.w)), o1[3] * rstd * w1[3] * silu_f(bf_hi(zw.w)));
                if (!dry) *(u32x4*)(proj + (size_t)(b * SEQ + c * 64 + tok) * PPITCH + 2 * GKD + GVD + hv * 128 + grp * 8) = r;
            }
            if (c + 1 < SEQ / 64) {
                const float bl_c = bl, al_c = al;
                if (wave >= 1) {
#pragma unroll
                    for (int i = 0; i < 7; ++i) {
                        const int id = (tq - 64) + 448 * i;
                        if (id < 3072) { const int tens = id >> 10, cc = (id >> 6) & 15, row = id & 63; const u32x4 w = raw[i];
                            *(LAS u32x4*)(lds + (tens == 0 ? GD_QN : (tens == 1 ? GD_KN : GD_VS)) + row * GD_P + cc * 16) = w;
                        }
                    }
                }
                if (wave == 1) {
                    const float beta = bl_c; float v = al_c;
#pragma unroll
                    for (int off = 1; off < 64; off <<= 1) { const float t = __shfl_up(v, off); if (lane_c >= off) v += t; }
                    const float g63 = __shfl(v, 63), eg = fexp(v);
                    gate[lane_c] = beta; gate[64 + lane_c] = v; gate[128 + lane_c] = eg; gate[192 + lane_c] = fexp(g63 - v); gate[256 + lane_c] = beta * eg;
                }
            }
            __syncthreads();
        }
    }
}

__device__ __forceinline__ void phase_final(const Args& a, int G, int bid, int wave_sgpr) {
    int tid_ = (wave_sgpr * 64 + (int)__builtin_amdgcn_mbcnt_hi(~0u, __builtin_amdgcn_mbcnt_lo(~0u, 0u))); asm volatile("" : "+v"(tid_)); const int tid = tid_, lane = tid & 63, wave = __builtin_amdgcn_readfirstlane(tid >> 6);
    const int gw = bid * NWAVES + wave, NGW = G * NWAVES;
    const u64* ssq = (const u64*)(a.ws + WS_SSQ) + (size_t)12 * MTOK; const bf16_t* xh = (const bf16_t*)(a.ws + WS_XB); const unsigned char* xl = a.ws + WS_XL;
    for (int m = gw; m < MTOK; m += NGW) {
        const float rstd = rstd_of(ssq, m);
#pragma unroll
        for (int j = 0; j < 2; ++j) {
            const size_t off = (size_t)m * DM + 8 * (lane + 64 * j);
            const u32x4 h = *(const u32x4*)(xh + off); const u32x2 l = *(const u32x2*)(xl + off);
            const f32x2 l0 = __builtin_amdgcn_cvt_pk_f32_fp8((int)l.x, false), l1 = __builtin_amdgcn_cvt_pk_f32_fp8((int)l.x, true), l2 = __builtin_amdgcn_cvt_pk_f32_fp8((int)l.y, false), l3 = __builtin_amdgcn_cvt_pk_f32_fp8((int)l.y, true);
            const f32x4 w0 = *(const f32x4*)(a.final_norm_w + 8 * (lane + 64 * j)), w1 = *(const f32x4*)(a.final_norm_w + 8 * (lane + 64 * j) + 4);
            f32x4 o0 = {bf_lo(h.x) + l0.x * 0.00390625f, bf_hi(h.x) + l0.y * 0.00390625f, bf_lo(h.y) + l1.x * 0.00390625f, bf_hi(h.y) + l1.y * 0.00390625f};
            f32x4 o1 = {bf_lo(h.z) + l2.x * 0.00390625f, bf_hi(h.z) + l2.y * 0.00390625f, bf_lo(h.w) + l3.x * 0.00390625f, bf_hi(h.w) + l3.y * 0.00390625f};
            *(f32x4*)(a.out + off) = o0 * rstd * w0; *(f32x4*)(a.out + off + 4) = o1 * rstd * w1;
        }
    }
}

constexpr int N_PHASES = 34;
__global__ void __launch_bounds__(NTHREADS, 2) fwd_kernel(Args a_in) {
    extern __shared__ __attribute__((aligned(16))) unsigned char lds_raw[];
    LAS unsigned char* lds = (LAS unsigned char*)lds_raw;
    cg::grid_group grid = cg::this_grid();
    const int wave_sgpr = __builtin_amdgcn_readfirstlane((int)(threadIdx.x >> 6));
    volatile LAS unsigned* xb_st = (volatile LAS unsigned*)(lds + LDS_BYTES - 8);
    if (threadIdx.x < 2) xb_st[threadIdx.x] = 0u;
    __syncthreads();
    const bool is_t0 = (wave_sgpr == 0) && (__builtin_amdgcn_mbcnt_hi(~0u, __builtin_amdgcn_mbcnt_lo(~0u, 0u)) == 0u);
    unsigned* xb_words = (unsigned*)(((const __attribute__((address_space(4))) Args*)__builtin_amdgcn_kernarg_segment_ptr())->ws + WS_XBAR);
    XcdBarrier xbar = xcd_barrier_post(xb_words, xb_st, is_t0);
    typedef const __attribute__((address_space(4))) Args* KArgs;
    const int ph_lo = ((KArgs)__builtin_amdgcn_kernarg_segment_ptr())->ph_lo, ph_hi = ((KArgs)__builtin_amdgcn_kernarg_segment_ptr())->ph_hi;
#pragma nounroll
    for (int ph = ph_lo; ph < ph_hi; ++ph) {
        KArgs ap = (KArgs)__builtin_amdgcn_kernarg_segment_ptr(); asm volatile("" : "+s"(ap));
        const Args a = *(const Args*)ap;
        int G = gridDim.x, bid = blockIdx.x; asm volatile("" : "+s"(G), "+s"(bid));
        bf16_t* Wb = (bf16_t*)(a.ws + WS_W); u64* ssq = (u64*)(a.ws + WS_SSQ); bf16_t* xb = (bf16_t*)(a.ws + WS_XB); bf16_t* big = (bf16_t*)(a.ws + WS_BIG);
        const int layer = (ph - 1) / 8, st = (ph - 1) % 8, im = layer >> 1; const bool is_gdn = layer & 1, mid = (ph > 0 && ph < N_PHASES - 1);
#ifndef PROBE_KIND
#define PROBE_KIND 0
#endif
        int nrep = 1;
        if (PROBE_KIND == 1 && mid && st != 3 && st != 4) nrep = 2;
        if (PROBE_KIND == 2 && mid && st == 4 && is_gdn) nrep = 2;
        if (PROBE_KIND == 3 && (ph == 0 || (mid && !is_gdn && (st == 3 || st == 4)))) nrep = 2;
        if (PROBE_KIND == 4 && mid && (st == 0 || st == 6)) nrep = 2;
#pragma nounroll
        for (int rp = 0; rp < nrep; ++rp) {
        const bool dry = (rp + 1 < nrep);
        if (rp > 0) xcd_barrier(xbar, is_t0);
        if (ph == 0) phase_prep(a, lds, G, bid, wave_sgpr);
        else if (ph == N_PHASES - 1) phase_final(a, G, bid, wave_sgpr);
        else {
            pg8::StaticOrder S;
            if (st == 0 || st == 6) {
                const int j = (st == 6);
                pg8::Gemm g{xb, Wb + W_FFNIN + (size_t)(layer * 2 + j) * SZ_FFNIN, MTOK, NFF, DM, DM}; S.init(MTOK, NFF, G, bid);
                EpiFfnIn E{big, ssq + (size_t)(layer * 3 + 2 * j) * MTOK};
                pg8::gemm_phase<EpiFfnIn, pg8::StaticOrder, true, true>(lds, g, S, E, wave_sgpr);
            } else if (st == 1 || st == 7 || st == 5) {
                pg8::Gemm g; EpiResid E; E.xin = a.x; E.first = (ph == 2); E.xh = xb; E.xl = a.ws + WS_XL;
                if (st == 5) {
                    if (!is_gdn) g = pg8::Gemm{(const bf16_t*)(a.ws + WS_AO), Wb + W_ATTNOUT + (size_t)im * SZ_ATTNOUT, MTOK, DM, AW, AW};
                    else g = pg8::Gemm{big + 2 * GKD + GVD, Wb + W_GDNOUT + (size_t)im * SZ_GDNOUT, MTOK, DM, GVD, PPITCH};
                    E.scale = 1.0f; E.ssqn = ssq + (size_t)(layer * 3 + 2) * MTOK;
                } else {
                    const int j = (st == 7);
                    g = pg8::Gemm{big, Wb + W_FFNOUT + (size_t)(layer * 2 + j) * SZ_FFNOUT, MTOK, DM, DFF, DFF};
                    E.scale = 0.5f; E.ssqn = ssq + (size_t)(j ? (layer + 1) * 3 : layer * 3 + 1) * MTOK;
                }
                if (dry) { E.scale = 0.f; E.ssqn = (u64*)(a.ws + WS_DUMMY); }
                S.init(MTOK, DM, G, bid);
                pg8::gemm_phase<EpiResid, pg8::StaticOrder, true, false>(lds, g, S, E, wave_sgpr);
            } else if (st == 2) {
                const u64* sq = ssq + (size_t)(layer * 3 + 1) * MTOK;
                if (!is_gdn) {
                    pg8::Gemm g{xb, Wb + W_ATTNIN + (size_t)im * SZ_ATTNIN, MTOK, NA, DM, DM}; S.init(MTOK, NA, G, bid);
                    EpiAttnIn E{big, sq, (const float*)(a.ws + WS_ROPE)};
                    pg8::gemm_phase<EpiAttnIn, pg8::StaticOrder, true, true>(lds, g, S, E, wave_sgpr);
                } else {
                    pg8::Gemm g{xb, Wb + W_GDNIN + (size_t)im * SZ_GDNIN, MTOK, NGP, DM, DM}; S.init(MTOK, NGP, G, bid);
                    EpiGdnIn E{big, (float*)(a.ws + WS_BA), sq, (bf16_t*)a.out};
                    pg8::gemm_phase<EpiGdnIn, pg8::StaticOrder, true, true>(lds, g, S, E, wave_sgpr);
                }
            } else if (st == 3) {
                if (!is_gdn) phase_attn(a, lds, G, bid, wave_sgpr);
                else { if (G >= 256) phase_gdn_pre(a, im, wave_sgpr, 0, 16, 0, G); else phase_gdn_pre(a, im, wave_sgpr, 0, 64, 0, G); }
            } else {
                if (!is_gdn) phase_attn_combine(a, G, bid, dry, wave_sgpr);
                else if (G >= 256) {
                    if (bid < NB * 16) phase_gdn(a, lds, G, bid, im, dry, wave_sgpr, xbar, is_t0, true);
                    else { for (int qd = 0; qd < 6; ++qd) { phase_gdn_pre(a, im, wave_sgpr, 16 + 8 * qd, 8, NB * 16, G - NB * 16); xcd_barrier(xbar, is_t0); } }
                } else phase_gdn(a, lds, G, bid, im, dry, wave_sgpr, xbar, is_t0, false);
            }
        }
        }
        if (ph + 1 < ph_hi) { if (ph_hi > (1 << 20)) grid.sync(); else xcd_barrier(xbar, is_t0); }
    }
}

#ifndef MK_ONE_LAUNCH
#define MK_ONE_LAUNCH 1
#endif
extern "C" void kernel_launch(void* const* d_in, const int* in_sizes, int n_in, void* d_out, int out_size, void* d_ws, size_t ws_size, hipStream_t stream) {
    static int grid = 0;
    if (grid == 0) {
        if (n_in != 13 || out_size != MTOK * DM || ws_size < WS_END) { fprintf(stderr, "kernel_launch: unexpected shapes (n_in %d out %d ws %zu)\n", n_in, out_size, ws_size); grid = -1; return; }
        int dev = 0, cus = 0, per_cu = 0;
        if (hipGetDevice(&dev) != hipSuccess || hipDeviceGetAttribute(&cus, hipDeviceAttributeMultiprocessorCount, dev) != hipSuccess) { grid = -1; return; }
        if (hipFuncSetAttribute((const void*)fwd_kernel, hipFuncAttributeMaxDynamicSharedMemorySize, LDS_BYTES) != hipSuccess) { fprintf(stderr, "kernel_launch: hipFuncSetAttribute failed\n"); grid = -1; return; }
        if (hipOccupancyMaxActiveBlocksPerMultiprocessor(&per_cu, (const void*)fwd_kernel, NTHREADS, LDS_BYTES) != hipSuccess || per_cu < 1) { fprintf(stderr, "kernel_launch: occupancy query says %d\n", per_cu); per_cu = 1; }
        (void)hipGetLastError();
        grid = cus * 1;
    }
    if (grid < 0) return;
    Args a{};
    a.x = (const float*)d_in[0]; a.norm_w = (const float*)d_in[1]; a.ffn_w_in = (const float*)d_in[2]; a.ffn_w_out = (const float*)d_in[3];
    a.attn_w_in = (const float*)d_in[4]; a.attn_w_out = (const float*)d_in[5]; a.gdn_w_in = (const float*)d_in[6]; a.gdn_conv_w = (const float*)d_in[7];
    a.gdn_a_log = (const float*)d_in[8]; a.gdn_dt_bias = (const float*)d_in[9]; a.gdn_norm_w = (const float*)d_in[10]; a.gdn_w_out = (const float*)d_in[11];
    a.final_norm_w = (const float*)d_in[12]; a.out = (float*)d_out; a.ws = (unsigned char*)d_ws;
    (void)hipMemsetAsync((unsigned char*)d_ws + WS_XBAR, 0, XCD_BAR_WORDS * sizeof(unsigned), stream);
#if MK_ONE_LAUNCH
    a.ph_lo = 0; a.ph_hi = N_PHASES;
    void* args[] = {&a};
    hipError_t e = hipLaunchCooperativeKernel((const void*)fwd_kernel, dim3(grid), dim3(NTHREADS), args, LDS_BYTES, stream);
    if (e != hipSuccess) fprintf(stderr, "cooperative launch failed: %s (grid %d)\n", hipGetErrorString(e), grid);
#else
    for (int ph = 0; ph < N_PHASES; ++ph) { a.ph_lo = ph; a.ph_hi = ph + 1; hipLaunchKernelGGL(fwd_kernel, dim3(grid), dim3(NTHREADS), LDS_BYTES, stream, a); }
#endif
}
```

```cpp
#include <hip/hip_runtime.h>
#include <hip/hip_cooperative_groups.h>
#include <cstdio>
#include <cstdint>
namespace cg = cooperative_groups;
namespace pg8 {
#define PG8_LAS __attribute__((address_space(3)))
typedef unsigned short bf16_t;
typedef short bf16x8 __attribute__((ext_vector_type(8)));
typedef float f32x4 __attribute__((ext_vector_type(4)));
typedef unsigned u32x4 __attribute__((ext_vector_type(4)));
constexpr int BM = 256, BK = 64, HALF = 128, HTB = HALF * BK * 2  , STAGE_BYTES = 8 * HTB, NXCD = 8, WGM = 8;

__host__ __device__ __forceinline__ int lds_byte(int r, int c) { const int st = (r >> 4) * 2 + (c >> 5), rr = r & 15, cc = c & 31, ob = rr * 64 + cc * 2; return st * 1024 + (ob ^ (((ob >> 9) & 1) << 5)); }
__host__ __device__ __forceinline__ void stage_rc(int b, int& R, int& C) { const int st = b / 1024, sb = b % 1024, swz = sb ^ (((sb >> 9) & 1) << 5); R = (st >> 1) * 16 + swz / 64; C = (st & 1) * 32 + (swz % 64) / 2; }
__host__ __device__ __forceinline__ int perm32(int rho) { const int n = rho >> 4, i = rho & 15; return 8 * (i >> 2) + 4 * n + (i & 3); }

struct Unit { int pm, pn; };
struct Gemm { const bf16_t* A; const bf16_t* Bt; int M, N, K, lda; };

struct StaticOrder {
    int nM, nN, nwg, G, c;
    __host__ __device__ void init(int M, int N, int G_, int c_) { nM = M / BM; nN = N / BM; nwg = nM * nN; G = G_; c = c_; }
    __host__ __device__ bool next(int i, Unit& u) const {
        const long L = (long)i * G + c; if (L >= nwg) return false;
        int wgid = (int)L; { const int q = nwg / NXCD, r = nwg % NXCD, xcd = wgid % NXCD, off = wgid / NXCD; wgid = (xcd < r ? xcd * (q + 1) : r * (q + 1) + (xcd - r) * q) + off; }
        const int nig = WGM * nN, gid = wgid / nig, fm = gid * WGM, gsz = (nM - fm) < WGM ? (nM - fm) : WGM;
        u.pm = fm + ((wgid % nig) % gsz); u.pn = (wgid % nig) / gsz; return true;
    }
    __device__ __forceinline__ void a_ready(const Unit&) const {}
    __device__ __forceinline__ void done(const Unit&) const {}
};
typedef __bf16 bf16x2_cv __attribute__((ext_vector_type(2))); typedef float f32x2_cv __attribute__((ext_vector_type(2)));
__device__ __forceinline__ unsigned cvt_pk_bf16(float lo, float hi) { const f32x2_cv v = {lo, hi}; return __builtin_bit_cast(unsigned, __builtin_convertvector(v, bf16x2_cv)); }
template <class Epi, class Sched, bool ALIGN_EPI = false, bool SP2 = false>
__device__ __forceinline__ void gemm_phase(PG8_LAS unsigned char* lds, const Gemm g, const Sched& S, const Epi& E, int wave_sgpr) {
    int tid_ = (wave_sgpr * 64 + (int)__builtin_amdgcn_mbcnt_hi(~0u, __builtin_amdgcn_mbcnt_lo(~0u, 0u))); asm volatile("" : "+v"(tid_)); const int tid = tid_, wid = __builtin_amdgcn_readfirstlane(tid >> 6), lane = tid & 63, wr = wid >> 2, wc = wid & 3, fr = lane & 15, fq = lane >> 4;
    const int K = g.K, nt = K / BK;
    unsigned voffA[2], voffB[2];
#pragma unroll
    for (int i = 0; i < 2; ++i) { int R, C; stage_rc(tid * 16 + i * 8192, R, C); const int Rb = Epi::PERM ? ((R & ~31) + perm32(R & 31)) : R;
        voffA[i] = (unsigned)(R * g.lda + C) * 2u; voffB[i] = (unsigned)(Rb * K + C) * 2u; }
    const size_t kstep = (size_t)(BK * 2);
    const size_t hstep = (size_t)HALF * K * 2;
    const size_t tstep = 2 * hstep; const size_t hstepA = (size_t)HALF * g.lda * 2, tstepA = 2 * hstepA;
    const unsigned ldsw = (unsigned)wid * 1024u;
    const int aoff = lds_byte(wr * 64 + fr, fq * 8), boff = lds_byte(wc * 32 + fr, fq * 8);
#define PG8_SA(b, h) (((b) * 2 + (h)) * HTB)
#define PG8_SB(b, h) ((4 + (b) * 2 + (h)) * HTB)
#define PG8_STAGE(bufoff, gbase, voff) do { _Pragma("unroll") for (int _i = 0; _i < 2; ++_i) \
        __builtin_amdgcn_global_load_lds((const unsigned*)((const char*)(gbase) + (voff)[_i]), (PG8_LAS unsigned*)(lds + (bufoff) + ldsw + _i * 8192), 16, 0, 0); } while (0)
#define PG8_LDA(dst, b, h) do { _Pragma("unroll") for (int m = 0; m < 4; ++m) _Pragma("unroll") for (int k = 0; k < 2; ++k) dst[m][k] = *(const PG8_LAS bf16x8*)(lds + PG8_SA(b, h) + aoff + m * 2048 + k * 1024); } while (0)
#define PG8_LDB(dst, b, h) do { _Pragma("unroll") for (int n = 0; n < 2; ++n) _Pragma("unroll") for (int k = 0; k < 2; ++k) dst[n][k] = *(const PG8_LAS bf16x8*)(lds + PG8_SB(b, h) + boff + n * 2048 + k * 1024); } while (0)
#define PG8_MMA(ai, bj, At, Bt) do { __builtin_amdgcn_s_setprio(1); _Pragma("unroll") for (int m = 0; m < 4; ++m) _Pragma("unroll") for (int n = 0; n < 2; ++n) _Pragma("unroll") for (int k = 0; k < 2; ++k) \
        acc[ai][bj][m][n] = __builtin_amdgcn_mfma_f32_16x16x32_bf16(Bt[n][k], At[m][k], acc[ai][bj][m][n], 0, 0, 0); __builtin_amdgcn_s_setprio(0); } while (0)
#define PG8_WAIT_V(n) asm volatile("s_waitcnt vmcnt(" #n ")" ::: "memory")
#define PG8_WAIT_L(n) asm volatile("s_waitcnt lgkmcnt(" #n ")" ::: "memory")
#define PG8_BAR __builtin_amdgcn_s_barrier()
#define PG8_SCHED __builtin_amdgcn_sched_barrier(0)
    Unit cur, nxt; int ui = 0;
    if (!S.next(0, cur)) return;
    f32x4 acc[2][2][4][2];
#pragma unroll
    for (int a = 0; a < 2; ++a)
#pragma unroll
        for (int b = 0; b < 2; ++b)
#pragma unroll
            for (int m = 0; m < 4; ++m)
#pragma unroll
                for (int n = 0; n < 2; ++n) acc[a][b][m][n] = (f32x4){0.f, 0.f, 0.f, 0.f};
    bf16x8 At[4][2], B0[2][2], B1[2][2];
    const char* cA = (const char*)g.A + (size_t)cur.pm * tstepA; const char* cB = (const char*)g.Bt + (size_t)cur.pn * tstep;
    S.a_ready(cur);
    if constexpr (SP2) {
        PG8_STAGE(PG8_SB(0, 0), cB, voffB); PG8_STAGE(PG8_SB(0, 1), cB + hstep, voffB); PG8_STAGE(PG8_SA(0, 0), cA, voffA); PG8_STAGE(PG8_SA(0, 1), cA + hstepA, voffA);
        if (wr == 1) PG8_BAR;
        PG8_WAIT_V(2); PG8_BAR;
        PG8_STAGE(PG8_SB(1, 0), cB + kstep, voffB); PG8_STAGE(PG8_SA(1, 0), cA + kstep, voffA); PG8_STAGE(PG8_SB(1, 1), cB + hstep + kstep, voffB);
        PG8_WAIT_V(6); PG8_BAR;
    } else {
        PG8_STAGE(PG8_SB(0, 0), cB, voffB); PG8_STAGE(PG8_SA(0, 0), cA, voffA); PG8_STAGE(PG8_SB(0, 1), cB + hstep, voffB); PG8_STAGE(PG8_SA(0, 1), cA + hstepA, voffA);
        if (wr == 1) PG8_BAR;
        PG8_WAIT_V(4); PG8_BAR;
        PG8_STAGE(PG8_SB(1, 0), cB + kstep, voffB); PG8_STAGE(PG8_SA(1, 0), cA + kstep, voffA); PG8_STAGE(PG8_SB(1, 1), cB + hstep + kstep, voffB);
        PG8_WAIT_V(6); PG8_BAR;
    }
    for (;;) {
        const bool has_next = S.next(ui + 1, nxt);
        const char* nA = has_next ? (const char*)g.A + (size_t)nxt.pm * tstepA : cA; const char* nB = has_next ? (const char*)g.Bt + (size_t)nxt.pn * tstep : cB;
        for (int t = 0; t < nt; t += 2) {
            const bool last = (t == nt - 2);
            const char* a1 = cA + (size_t)(t + 1) * kstep;
            const char* a2 = last ? nA : cA + (size_t)(t + 2) * kstep; const char* b2 = last ? nB : cB + (size_t)(t + 2) * kstep;
            const char* a3 = a2 + kstep; const char* b3 = b2 + kstep;
            if (last && has_next) S.a_ready(nxt);
            if constexpr (SP2) {
            PG8_LDB(B0, 0, 0); PG8_LDB(B1, 0, 1); PG8_SCHED; PG8_LDA(At, 0, 0); PG8_STAGE(PG8_SA(1, 1), a1 + hstepA, voffA);
            PG8_WAIT_V(8); PG8_WAIT_L(0); PG8_BAR; PG8_MMA(0, 0, At, B0); PG8_MMA(0, 1, At, B1); PG8_BAR; PG8_SCHED;
            PG8_LDA(At, 0, 1); PG8_STAGE(PG8_SB(0, 0), b2, voffB); PG8_STAGE(PG8_SB(0, 1), b2 + hstep, voffB); PG8_STAGE(PG8_SA(0, 0), a2, voffA);
            PG8_WAIT_V(8); PG8_WAIT_L(0); PG8_BAR; PG8_MMA(1, 0, At, B0); PG8_MMA(1, 1, At, B1); PG8_BAR; PG8_SCHED;
            PG8_LDB(B0, 1, 0); PG8_LDB(B1, 1, 1); PG8_SCHED; PG8_LDA(At, 1, 0); PG8_STAGE(PG8_SA(0, 1), a2 + hstepA, voffA);
            PG8_WAIT_V(8); PG8_WAIT_L(0); PG8_BAR; PG8_MMA(0, 0, At, B0); PG8_MMA(0, 1, At, B1); PG8_BAR; PG8_SCHED;
            PG8_LDA(At, 1, 1); PG8_STAGE(PG8_SB(1, 0), b3, voffB); PG8_STAGE(PG8_SB(1, 1), b3 + hstep, voffB); PG8_STAGE(PG8_SA(1, 0), a3, voffA);
            PG8_WAIT_V(8); PG8_WAIT_L(0); PG8_BAR; PG8_MMA(1, 0, At, B0); PG8_MMA(1, 1, At, B1); PG8_BAR; PG8_SCHED;
            } else {
            PG8_LDB(B0, 0, 0); PG8_SCHED; PG8_LDA(At, 0, 0); PG8_STAGE(PG8_SA(1, 1), a1 + hstepA, voffA);
            PG8_WAIT_L(8); PG8_BAR; PG8_WAIT_L(0); PG8_MMA(0, 0, At, B0); PG8_BAR; PG8_SCHED;
            PG8_LDB(B1, 0, 1); PG8_STAGE(PG8_SB(0, 0), b2, voffB);
            PG8_BAR; PG8_WAIT_L(0); PG8_MMA(0, 1, At, B1); PG8_BAR;
            PG8_LDA(At, 0, 1); PG8_STAGE(PG8_SA(0, 0), a2, voffA);
            PG8_BAR; PG8_WAIT_L(0); PG8_MMA(1, 0, At, B0); PG8_BAR; PG8_SCHED;
            PG8_STAGE(PG8_SB(0, 1), b2 + hstep, voffB);
            PG8_WAIT_V(6); PG8_BAR; PG8_MMA(1, 1, At, B1); PG8_BAR;
            PG8_LDB(B0, 1, 0); PG8_SCHED; PG8_LDA(At, 1, 0); PG8_STAGE(PG8_SA(0, 1), a2 + hstepA, voffA);
            PG8_WAIT_L(8); PG8_BAR; PG8_WAIT_L(0); PG8_MMA(0, 0, At, B0); PG8_BAR; PG8_SCHED;
            PG8_LDB(B1, 1, 1); PG8_STAGE(PG8_SB(1, 0), b3, voffB);
            PG8_BAR; PG8_WAIT_L(0); PG8_MMA(0, 1, At, B1); PG8_BAR;
            PG8_LDA(At, 1, 1); PG8_STAGE(PG8_SA(1, 0), a3, voffA);
            PG8_BAR; PG8_WAIT_L(0); PG8_MMA(1, 0, At, B0); PG8_BAR; PG8_SCHED;
            PG8_STAGE(PG8_SB(1, 1), b3 + hstep, voffB);
            PG8_WAIT_V(6); PG8_BAR; PG8_MMA(1, 1, At, B1); PG8_BAR;
            }
        }
        if constexpr (ALIGN_EPI) { if (wr == 0) PG8_BAR; }
        if constexpr (!Epi::AFTER_DRAIN) { E(acc, cur, wr, wc, fr, fq); S.done(cur); }
        if (!has_next) break;
#pragma unroll
        for (int a = 0; a < 2; ++a)
#pragma unroll
            for (int b = 0; b < 2; ++b)
#pragma unroll
                for (int m = 0; m < 4; ++m)
#pragma unroll
                    for (int n = 0; n < 2; ++n) acc[a][b][m][n] = (f32x4){0.f, 0.f, 0.f, 0.f};
        cur = nxt; cA = nA; cB = nB; ++ui;
        if constexpr (ALIGN_EPI) { if (wr == 1) PG8_BAR; }
    }
    PG8_WAIT_V(0);
    if constexpr (!ALIGN_EPI) { if (wr == 0) PG8_BAR; }
    PG8_BAR;
    if constexpr (Epi::AFTER_DRAIN) { E.fused(acc, cur, wr, wc, fr, fq, lds, wid, lane); S.done(cur); }
#undef PG8_SA
#undef PG8_SB
#undef PG8_STAGE
#undef PG8_LDA
#undef PG8_LDB
#undef PG8_MMA
#undef PG8_WAIT_V
#undef PG8_WAIT_L
#undef PG8_BAR
#undef PG8_SCHED
}
}

#define LAS __attribute__((address_space(3)))
typedef unsigned short bf16_t;
typedef short bf16x8 __attribute__((ext_vector_type(8)));
typedef float f32x4 __attribute__((ext_vector_type(4)));
typedef float f32x2 __attribute__((ext_vector_type(2)));
typedef unsigned u32x4 __attribute__((ext_vector_type(4)));
typedef unsigned u32x2 __attribute__((ext_vector_type(2)));

constexpr int SEQ = 4096, NB = 8, MTOK = NB * SEQ, DM = 1024, DFF = 2816, NFF = 2 * DFF, DEPTH = 4;
constexpr int AW = 1536, NA = 3 * AW, HD = 128;
constexpr int GKD = 1024, GVD = 2048, GCONV = 4096, NGSRC = 6176, NGP = 6400, PPITCH = 6144;
constexpr float RMS_EPS = 1e-6f;
constexpr int NTHREADS = 512, NWAVES = 8;
constexpr int LDS_BYTES = 160 * 1024;

constexpr size_t MiB = 1u << 20;
constexpr size_t WS_SSQ = 0;
constexpr size_t WS_ROPE = 4 * MiB;
constexpr size_t WS_BA = 6 * MiB;
constexpr size_t WS_XB = 10 * MiB;
constexpr size_t WS_W = 74 * MiB;
constexpr size_t WS_BIG = 266 * MiB;
constexpr size_t WS_AO = 554 * MiB;
constexpr size_t WS_DUMMY = 650 * MiB;
constexpr size_t WS_XBAR = 651 * MiB;
constexpr size_t WS_XL = 652 * MiB;
constexpr size_t WS_HALO_UNUSED = 0;
constexpr size_t WS_END = 684 * MiB;
constexpr size_t W_FFNIN = 0, SZ_FFNIN = (size_t)NFF * DM;
constexpr size_t W_FFNOUT = W_FFNIN + 8 * SZ_FFNIN, SZ_FFNOUT = (size_t)DM * DFF;
constexpr size_t W_ATTNIN = W_FFNOUT + 8 * SZ_FFNOUT, SZ_ATTNIN = (size_t)NA * DM;
constexpr size_t W_ATTNOUT = W_ATTNIN + 2 * SZ_ATTNIN, SZ_ATTNOUT = (size_t)DM * AW;
constexpr size_t W_GDNIN = W_ATTNOUT + 2 * SZ_ATTNOUT, SZ_GDNIN = (size_t)NGP * DM;
constexpr size_t W_GDNOUT = W_GDNIN + 2 * SZ_GDNIN, SZ_GDNOUT = (size_t)DM * GVD;
constexpr size_t W_TOTAL = W_GDNOUT + 2 * SZ_GDNOUT;
static_assert(WS_W + W_TOTAL * 2 <= WS_BIG, "weights fit");
static_assert(WS_BIG + (size_t)MTOK * PPITCH * 2 <= WS_END && WS_BIG + (size_t)MTOK * NA * 2 <= WS_AO && WS_AO + (size_t)MTOK * AW * 2 <= WS_END, "big region");

__device__ __forceinline__ float bf_lo(unsigned w) { return __uint_as_float(w << 16); }
__device__ __forceinline__ float bf_hi(unsigned w) { return __uint_as_float(w & 0xffff0000u); }
__device__ __forceinline__ unsigned pk2(float lo, float hi) { return pg8::cvt_pk_bf16(lo, hi); }
typedef unsigned long long u64;
__device__ __forceinline__ float rstd_of(const u64* ssq, int row) { return rsqrtf((float)ssq[row] * (1.0f / (1048576.0f * DM)) + RMS_EPS); }
__device__ __forceinline__ float fexp(float x) { return __builtin_amdgcn_exp2f(x * 1.4426950408889634f); }
__device__ __forceinline__ float silu_f(float x) { return x * __builtin_amdgcn_rcpf(1.0f + __builtin_amdgcn_exp2f(x * -1.4426950408889634f)); }

struct EpiFfnIn {
    static constexpr bool PERM = true, AFTER_DRAIN = false;
    bf16_t* act; const u64* ssq;
    __device__ __forceinline__ void operator()(const f32x4 (&acc)[2][2][4][2], const pg8::Unit& u, int wr, int wc, int fr, int fq) const {
        const int row0 = u.pm * 256 + wr * 64 + fr, col0 = u.pn * 128 + wc * 32 + 8 * fq;
#pragma unroll
        for (int ai = 0; ai < 2; ++ai)
#pragma unroll
            for (int m = 0; m < 4; ++m) {
                const int row = row0 + ai * 128 + m * 16;
                const float rstd = rstd_of(ssq, row);
                const f32x4 g0 = acc[ai][0][m][0] * rstd, g1 = acc[ai][0][m][1] * rstd, u0 = acc[ai][1][m][0] * rstd, u1 = acc[ai][1][m][1] * rstd;
                u32x4 w;
                w.x = pk2(silu_f(g0[0]) * u0[0], silu_f(g0[1]) * u0[1]); w.y = pk2(silu_f(g0[2]) * u0[2], silu_f(g0[3]) * u0[3]);
                w.z = pk2(silu_f(g1[0]) * u1[0], silu_f(g1[1]) * u1[1]); w.w = pk2(silu_f(g1[2]) * u1[2], silu_f(g1[3]) * u1[3]);
                *(u32x4*)(act + (size_t)row * DFF + col0) = w;
            }
    }
};
struct EpiResid {
    static constexpr bool PERM = true, AFTER_DRAIN = false;
    const float* xin; bf16_t* xh; unsigned char* xl; u64* ssqn; float scale; int first;
    __device__ __forceinline__ void operator()(const f32x4 (&acc)[2][2][4][2], const pg8::Unit& u, int wr, int wc, int fr, int fq) const {
        const int row0 = u.pm * 256 + wr * 64 + fr, col0 = u.pn * 256 + wc * 32 + 8 * fq;
#pragma unroll
        for (int ai = 0; ai < 2; ++ai)
#pragma unroll
            for (int m = 0; m < 4; ++m) {
                const int row = row0 + ai * 128 + m * 16; float ss = 0.f;
#pragma unroll
                for (int bj = 0; bj < 2; ++bj) {
                    const size_t off = (size_t)row * DM + col0 + bj * 128;
                    f32x4 a, b;
                    if (first) { a = *(const f32x4*)(xin + off); b = *(const f32x4*)(xin + off + 4); }
                    else {
                        const u32x4 h = *(const u32x4*)(xh + off); const u32x2 l = *(const u32x2*)(xl + off);
                        const f32x2 l0 = __builtin_amdgcn_cvt_pk_f32_fp8((int)l.x, false), l1 = __builtin_amdgcn_cvt_pk_f32_fp8((int)l.x, true), l2 = __builtin_amdgcn_cvt_pk_f32_fp8((int)l.y, false), l3 = __builtin_amdgcn_cvt_pk_f32_fp8((int)l.y, true);
                        a = (f32x4){bf_lo(h.x) + l0.x * 0.00390625f, bf_hi(h.x) + l0.y * 0.00390625f, bf_lo(h.y) + l1.x * 0.00390625f, bf_hi(h.y) + l1.y * 0.00390625f};
                        b = (f32x4){bf_lo(h.z) + l2.x * 0.00390625f, bf_hi(h.z) + l2.y * 0.00390625f, bf_lo(h.w) + l3.x * 0.00390625f, bf_hi(h.w) + l3.y * 0.00390625f};
                    }
                    a = a + acc[ai][bj][m][0] * scale; b = b + acc[ai][bj][m][1] * scale;
                    u32x4 w; w.x = pk2(a[0], a[1]); w.y = pk2(a[2], a[3]); w.z = pk2(b[0], b[1]); w.w = pk2(b[2], b[3]);
                    *(u32x4*)(xh + off) = w;
#define LO8(x, hbits) fminf(fmaxf(((x) - (hbits)) * 256.0f, -400.f), 400.f)
                    int q0 = 0, q1 = 0;
                    q0 = __builtin_amdgcn_cvt_pk_fp8_f32(LO8(a[0], bf_lo(w.x)), LO8(a[1], bf_hi(w.x)), q0, false); q0 = __builtin_amdgcn_cvt_pk_fp8_f32(LO8(a[2], bf_lo(w.y)), LO8(a[3], bf_hi(w.y)), q0, true);
                    q1 = __builtin_amdgcn_cvt_pk_fp8_f32(LO8(b[0], bf_lo(w.z)), LO8(b[1], bf_hi(w.z)), q1, false); q1 = __builtin_amdgcn_cvt_pk_fp8_f32(LO8(b[2], bf_lo(w.w)), LO8(b[3], bf_hi(w.w)), q1, true);
#undef LO8
                    *(u32x2*)(xl + off) = (u32x2){(unsigned)q0, (unsigned)q1};
                    ss += (a[0] * a[0] + a[1] * a[1]) + (a[2] * a[2] + a[3] * a[3]) + (b[0] * b[0] + b[1] * b[1]) + (b[2] * b[2] + b[3] * b[3]);
                }
                ss += __shfl_xor(ss, 16); ss += __shfl_xor(ss, 32);
                if (fq == 0) atomicAdd(ssqn + row, (u64)(ss * 1048576.0f));
            }
    }
};
struct EpiAttnIn {
    static constexpr bool PERM = true, AFTER_DRAIN = false;
    bf16_t* qkv; const u64* ssq; const float* rope;
    __device__ __forceinline__ void operator()(const f32x4 (&acc)[2][2][4][2], const pg8::Unit& u, int wr, int wc, int fr, int fq) const {
        const int row0 = u.pm * 256 + wr * 64 + fr, colt = u.pn * 256, col0 = colt + wc * 32 + 8 * fq;
        const bool rot = colt < 2 * AW; const int i0 = 16 * wc + 4 * fq;
#pragma unroll
        for (int ai = 0; ai < 2; ++ai)
#pragma unroll
            for (int m = 0; m < 4; ++m) {
                const int row = row0 + ai * 128 + m * 16, pos = row & (SEQ - 1);
                const float rstd = rstd_of(ssq, row);
                f32x4 c = {1.f, 1.f, 1.f, 1.f}, s = {0.f, 0.f, 0.f, 0.f};
                if (rot) { c = *(const f32x4*)(rope + (size_t)pos * 64 + i0); s = *(const f32x4*)(rope + (size_t)SEQ * 64 + (size_t)pos * 64 + i0); }
#pragma unroll
                for (int bj = 0; bj < 2; ++bj) {
                    const f32x4 v0 = acc[ai][bj][m][0] * rstd, v1 = acc[ai][bj][m][1] * rstd;
                    const f32x4 o0 = v0 * c - v1 * s, o1 = v1 * c + v0 * s;
                    u32x4 w; w.x = pk2(o0[0], o0[1]); w.y = pk2(o0[2], o0[3]); w.z = pk2(o1[0], o1[1]); w.w = pk2(o1[2], o1[3]);
                    *(u32x4*)(qkv + (size_t)row * NA + col0 + bj * 128) = w;
                }
            }
    }
};
struct EpiGdnIn {
    static constexpr bool PERM = true, AFTER_DRAIN = false;
    bf16_t* proj; float* ba; const u64* ssq; bf16_t* halo;
    __device__ __forceinline__ void operator()(const f32x4 (&acc)[2][2][4][2], const pg8::Unit& u, int wr, int wc, int fr, int fq) const {
        const int row0 = u.pm * 256 + wr * 64 + fr, col0 = u.pn * 256 + wc * 32 + 8 * fq;
        const bool tail = (u.pn * 256 >= PPITCH);
#pragma unroll
        for (int ai = 0; ai < 2; ++ai)
#pragma unroll
            for (int m = 0; m < 4; ++m) {
                const int row = row0 + ai * 128 + m * 16;
                const float rstd = rstd_of(ssq, row);
                if (!tail) {
#pragma unroll
                    for (int bj = 0; bj < 2; ++bj) {
                        const f32x4 v0 = acc[ai][bj][m][0] * rstd, v1 = acc[ai][bj][m][1] * rstd;
                        u32x4 w; w.x = pk2(v0[0], v0[1]); w.y = pk2(v0[2], v0[3]); w.z = pk2(v1[0], v1[1]); w.w = pk2(v1[2], v1[3]);
                        *(u32x4*)(proj + (size_t)row * PPITCH + col0 + bj * 128) = w;
                        if (fr >= 13 && u.pn * 256 < GCONV) *(u32x4*)(halo + ((size_t)(row >> 4) * 3 + (fr - 13)) * GCONV + col0 + bj * 128) = w;
                    }
                } else if (wc == 0) {
                    *(f32x4*)(ba + (size_t)row * 32 + 8 * fq) = acc[ai][0][m][0] * rstd;
                    *(f32x4*)(ba + (size_t)row * 32 + 8 * fq + 4) = acc[ai][0][m][1] * rstd;
                }
            }
    }
};

struct Args {
    const float* x; const float* norm_w; const float* ffn_w_in; const float* ffn_w_out; const float* attn_w_in; const float* attn_w_out;
    const float* gdn_w_in; const float* gdn_conv_w; const float* gdn_a_log; const float* gdn_dt_bias; const float* gdn_norm_w; const float* gdn_w_out; const float* final_norm_w;
    float* out; unsigned char* ws; int ph_lo, ph_hi;
};

__device__ __forceinline__ float wave_sum(float v) {
#pragma unroll
    for (int o = 1; o < 64; o <<= 1) v += __shfl_xor(v, o);
    return v;
}
__device__ __forceinline__ float wave_max(float v) {
#pragma unroll
    for (int o = 1; o < 64; o <<= 1) v = fmaxf(v, __shfl_xor(v, o));
    return v;
}

enum { MAP_ID = 0, MAP_FFNIN = 1, MAP_ATTNIN = 2, MAP_GDNIN = 3 };
template <int MAP> __device__ __forceinline__ int srcmap(int n, float& rs) {
    rs = 1.0f;
    if (MAP == MAP_ID) return n;
    if (MAP == MAP_FFNIN) { const int t = n >> 8, c = n & 255; return (c < 128) ? t * 128 + c : DFF + t * 128 + (c - 128); }
    if (MAP == MAP_ATTNIN) { const int sec = n / AW, r = n - sec * AW, hh = r >> 7, p = r & 127;
        const int e = (sec < 2) ? (64 * ((p >> 2) & 1) + 16 * (p >> 5) + 4 * ((p >> 3) & 3) + (p & 3)) : p;
        if (sec == 0) rs = 0.08838834764831845f;
        return sec * AW + hh * 128 + e; }
      return (n < NGSRC) ? n : -1;
}
template <int MAP> __device__ __forceinline__ void convert_matrix(const float* W, int K, int Nsrc, int Nd, bf16_t* WT, const float* nw, int gw, int NGW, LAS float* scr, int lane) {
    const int nblk = Nd / 32, nitems = (K / 64) * nblk;
    for (int item = gw; item < nitems; item += NGW) {
        const int kb = item / nblk, nb = item - kb * nblk, k0 = 64 * kb, n0 = 32 * nb;
        float rs; const int sc = srcmap<MAP>(n0 + (lane & 31), rs);
#pragma unroll 8
        for (int i = 0; i < 32; ++i) { const int kk = 2 * i + (lane >> 5);
            float v = 0.f; if (sc >= 0) { v = W[(size_t)(k0 + kk) * Nsrc + sc] * rs; if (nw) v *= nw[k0 + kk]; }
            scr[kk * 33 + (lane & 31)] = v; }
        __builtin_amdgcn_fence(__ATOMIC_RELEASE, "wavefront"); __builtin_amdgcn_wave_barrier(); __builtin_amdgcn_fence(__ATOMIC_ACQUIRE, "wavefront");
        const int c = lane & 7;
#pragma unroll
        for (int j = 0; j < 4; ++j) { const int n = (lane >> 3) + 8 * j; const LAS float* s = scr + (8 * c) * 33 + n;
            u32x4 o; o.x = pk2(s[0 * 33], s[1 * 33]); o.y = pk2(s[2 * 33], s[3 * 33]); o.z = pk2(s[4 * 33], s[5 * 33]); o.w = pk2(s[6 * 33], s[7 * 33]);
            *(u32x4*)(WT + (size_t)(n0 + n) * K + k0 + 8 * c) = o; }
        __builtin_amdgcn_fence(__ATOMIC_RELEASE, "wavefront"); __builtin_amdgcn_wave_barrier(); __builtin_amdgcn_fence(__ATOMIC_ACQUIRE, "wavefront");
    }
}


__device__ __forceinline__ int srcmap_rt(int map, int n, float& rs) {
    rs = 1.0f;
    if (map == MAP_ID) return n;
    if (map == MAP_FFNIN) { const int t = n >> 8, c = n & 255; return (c < 128) ? t * 128 + c : DFF + t * 128 + (c - 128); }
    if (map == MAP_ATTNIN) { const int sec = n / AW, r = n - sec * AW, hh = r >> 7, p = r & 127;
        const int e = (sec < 2) ? (64 * ((p >> 2) & 1) + 16 * (p >> 5) + 4 * ((p >> 3) & 3) + (p & 3)) : p;
        if (sec == 0) rs = 0.08838834764831845f;
        return sec * AW + hh * 128 + e; }
    return (n < NGSRC) ? n : -1;
}
constexpr int CV_PITCH = 67;
constexpr int CV_N0 = 8 * (DM / 64) * (NFF / 64), CV_N1 = CV_N0 + 8 * (DFF / 64) * (DM / 64), CV_N2 = CV_N1 + 2 * (DM / 64) * (NA / 64), CV_N3 = CV_N2 + 2 * (AW / 64) * (DM / 64),
              CV_N4 = CV_N3 + 2 * (DM / 64) * (NGP / 64), CV_N5 = CV_N4 + 2 * (GVD / 64) * (DM / 64);
__device__ __forceinline__ void convert_all(const Args& a, int gw, int NGW, LAS float* scr, int lane) {
    bf16_t* Wb = (bf16_t*)(a.ws + WS_W);
#pragma unroll 1
    for (int item = gw; item < CV_N5; item += NGW) {
        const float* W; bf16_t* WT; const float* nw = nullptr; int K, Nsrc, Nd, map, local;
        if (item < CV_N0) { const int per = (DM / 64) * (NFF / 64), idx = item / per; local = item - idx * per;
            W = a.ffn_w_in + (size_t)idx * DM * NFF; WT = Wb + W_FFNIN + (size_t)idx * SZ_FFNIN; nw = a.norm_w + (size_t)((idx >> 1) * 3 + 2 * (idx & 1)) * DM; K = DM; Nsrc = NFF; Nd = NFF; map = MAP_FFNIN; }
        else if (item < CV_N1) { const int r = item - CV_N0, per = (DFF / 64) * (DM / 64), idx = r / per; local = r - idx * per;
            W = a.ffn_w_out + (size_t)idx * DFF * DM; WT = Wb + W_FFNOUT + (size_t)idx * SZ_FFNOUT; K = DFF; Nsrc = DM; Nd = DM; map = MAP_ID; }
        else if (item < CV_N2) { const int r = item - CV_N1, per = (DM / 64) * (NA / 64), idx = r / per; local = r - idx * per;
            W = a.attn_w_in + (size_t)idx * DM * NA; WT = Wb + W_ATTNIN + (size_t)idx * SZ_ATTNIN; nw = a.norm_w + (size_t)((2 * idx) * 3 + 1) * DM; K = DM; Nsrc = NA; Nd = NA; map = MAP_ATTNIN; }
        else if (item < CV_N3) { const int r = item - CV_N2, per = (AW / 64) * (DM / 64), idx = r / per; local = r - idx * per;
            W = a.attn_w_out + (size_t)idx * AW * DM; WT = Wb + W_ATTNOUT + (size_t)idx * SZ_ATTNOUT; K = AW; Nsrc = DM; Nd = DM; map = MAP_ID; }
        else if (item < CV_N4) { const int r = item - CV_N3, per = (DM / 64) * (NGP / 64), idx = r / per; local = r - idx * per;
            W = a.gdn_w_in + (size_t)idx * DM * NGSRC; WT = Wb + W_GDNIN + (size_t)idx * SZ_GDNIN; nw = a.norm_w + (size_t)((2 * idx + 1) * 3 + 1) * DM; K = DM; Nsrc = NGSRC; Nd = NGP; map = MAP_GDNIN; }
        else { const int r = item - CV_N4, per = (GVD / 64) * (DM / 64), idx = r / per; local = r - idx * per;
            W = a.gdn_w_out + (size_t)idx * GVD * DM; WT = Wb + W_GDNOUT + (size_t)idx * SZ_GDNOUT; K = GVD; Nsrc = DM; Nd = DM; map = MAP_ID; }
        const int nblk = Nd >> 6, kb = local / nblk, nb = local - kb * nblk, k0 = 64 * kb, n0 = 64 * nb;
        const int nq = lane & 15, kr = lane >> 4;
        float rs; const int sc = srcmap_rt(map, n0 + 4 * nq, rs);
        f32x4 v[16];
#pragma unroll
        for (int i = 0; i < 16; ++i) v[i] = (sc >= 0) ? __builtin_nontemporal_load((const f32x4*)(W + (size_t)(k0 + 4 * i + kr) * Nsrc + sc)) : (f32x4){0.f, 0.f, 0.f, 0.f};
#pragma unroll
        for (int i = 0; i < 16; ++i) { const int kk = 4 * i + kr; const float s = nw ? rs * nw[k0 + kk] : rs; LAS float* d = scr + kk * CV_PITCH + 4 * nq;
            d[0] = v[i][0] * s; d[1] = v[i][1] * s; d[2] = v[i][2] * s; d[3] = v[i][3] * s; }
        __builtin_amdgcn_fence(__ATOMIC_RELEASE, "wavefront"); __builtin_amdgcn_wave_barrier(); __builtin_amdgcn_fence(__ATOMIC_ACQUIRE, "wavefront");
        const int c = lane & 7;
#pragma unroll
        for (int o = 0; o < 8; ++o) { const int n = (lane >> 3) + 8 * o; const LAS float* s = scr + (8 * c) * CV_PITCH + n;
            u32x4 w; w.x = pk2(s[0 * CV_PITCH], s[1 * CV_PITCH]); w.y = pk2(s[2 * CV_PITCH], s[3 * CV_PITCH]); w.z = pk2(s[4 * CV_PITCH], s[5 * CV_PITCH]); w.w = pk2(s[6 * CV_PITCH], s[7 * CV_PITCH]);
            *(u32x4*)(WT + (size_t)(n0 + n) * K + k0 + 8 * c) = w; }
        __builtin_amdgcn_fence(__ATOMIC_RELEASE, "wavefront"); __builtin_amdgcn_wave_barrier(); __builtin_amdgcn_fence(__ATOMIC_ACQUIRE, "wavefront");
    }
}

__device__ __forceinline__ void phase_prep(const Args& a, LAS unsigned char* lds, int G, int bid, int wave_sgpr) {
    int tid_ = (wave_sgpr * 64 + (int)__builtin_amdgcn_mbcnt_hi(~0u, __builtin_amdgcn_mbcnt_lo(~0u, 0u))); asm volatile("" : "+v"(tid_)); const int tid = tid_, lane = tid & 63, wave = __builtin_amdgcn_readfirstlane(tid >> 6);
    const int gw = bid * NWAVES + wave, NGW = G * NWAVES;
    LAS float* scr = (LAS float*)(lds + wave * (64 * CV_PITCH * 4));
    convert_all(a, gw, NGW, scr, lane);
    u64* ssq = (u64*)(a.ws + WS_SSQ); bf16_t* xb = (bf16_t*)(a.ws + WS_XB);
    for (int m = gw; m < MTOK; m += NGW) {
        const f32x4* xr = (const f32x4*)(a.x + (size_t)m * DM) + lane; u32x2* o8 = (u32x2*)(xb + (size_t)m * DM) + lane; float s = 0.f;
#pragma unroll
        for (int j = 0; j < 4; ++j) { const f32x4 v = xr[64 * j]; s += (v[0] * v[0] + v[1] * v[1]) + (v[2] * v[2] + v[3] * v[3]); u32x2 w; w.x = pk2(v[0], v[1]); w.y = pk2(v[2], v[3]); o8[64 * j] = w; }
        s = wave_sum(s); if (lane == 0) ssq[m] = (u64)(s * 1048576.0f);
    }
    for (size_t i = (size_t)bid * NTHREADS + tid; i < (size_t)12 * MTOK; i += (size_t)G * NTHREADS) ssq[MTOK + i] = 0ull;
    float* rope = (float*)(a.ws + WS_ROPE);
    for (int i = bid * NTHREADS + tid; i < SEQ * 64; i += G * NTHREADS) {
        const int pos = i >> 6, j = i & 63;
        const float inv = 1.0f / powf(10000.0f, (float)(2 * j) * (1.0f / 128.0f));
        const float ang = (float)pos * inv;
        const double ad = (double)ang; const double n = rint(ad * 0.15915494309189535); const float r = (float)(ad - n * 6.283185307179586);
        rope[i] = __cosf(r); rope[SEQ * 64 + i] = __sinf(r);
    }
}


constexpr int ATT_UNITS = NB * 3 * 4 * 32, ATT_KP = 272, ATT_VP = 288  , ATT_VT_OFF = 256 * ATT_KP;
static_assert(ATT_VT_OFF + 256 * ATT_VP <= LDS_BYTES - 8, "attention lds");
struct AttUnit { int d, head, i0; size_t tokbase; };
__device__ __forceinline__ AttUnit att_decode(int u) {
    const int blk32 = u & 31, hq = (u >> 5) & 3, gq = u >> 7, g = gq % 3, b = gq / 3, dsh = 2 * g, nblk = 32 >> dsh, r = blk32 / nblk, ib = blk32 - r * nblk;
    AttUnit U; U.d = 1 << dsh; U.head = g * 4 + hq; U.i0 = ib * 128; U.tokbase = (size_t)b * SEQ + r; return U;
}
__device__ __forceinline__ void att_issue(const bf16_t* qkv, int u, int tid, int wave, int l15, int lq, u32x4 (&kreg)[8], u32x4 (&vreg)[8], u32x4 (&qn)[4]) {
    const AttUnit U = att_decode(u);
    const u32x4 zero = {0u, 0u, 0u, 0u};
    asm volatile("" : "+v"(tid));
#pragma unroll
    for (int i = 0; i < 8; ++i) { const int idx = U.i0 - 128 + (tid >> 4) + 32 * i;
        kreg[i] = (idx >= 0) ? *(const u32x4*)(qkv + (U.tokbase + (size_t)idx * U.d) * NA + AW + U.head * 128 + (tid & 15) * 8) : zero; }
#pragma unroll
    for (int i = 0; i < 8; ++i) { const int idx = U.i0 - 128 + (tid >> 4) + 32 * i;
        vreg[i] = (idx >= 0) ? *(const u32x4*)(qkv + (U.tokbase + (size_t)idx * U.d) * NA + 2 * AW + U.head * 128 + (tid & 15) * 8) : zero; }
    const size_t qtok = U.tokbase + (size_t)(U.i0 + 16 * wave + l15) * U.d;
#pragma unroll
    for (int es = 0; es < 4; ++es) qn[es] = *(const u32x4*)(qkv + qtok * NA + U.head * 128 + es * 32 + 8 * lq);
}
__device__ __forceinline__ void phase_attn(const Args& a, LAS unsigned char* lds, int G, int bid, int wave_sgpr) {
    int tid_ = (wave_sgpr * 64 + (int)__builtin_amdgcn_mbcnt_hi(~0u, __builtin_amdgcn_mbcnt_lo(~0u, 0u))); asm volatile("" : "+v"(tid_)); const int tid = tid_, lane = tid & 63, wave = __builtin_amdgcn_readfirstlane(tid >> 6);
    const int l15 = lane & 15, lq = lane >> 4, kb0 = 2 * (wave >> 1);
    const bf16_t* qkv = (const bf16_t*)(a.ws + WS_BIG); bf16_t* ao = (bf16_t*)(a.ws + WS_AO); float* lse = (float*)(a.ws + WS_BA);
    LAS unsigned char* Ks = lds; LAS unsigned char* Vt = lds + ATT_VT_OFF;
    u32x4 kreg[8], vreg[8], qn[4];
    int u = ((G & 7) == 0) ? (bid & 7) * (G >> 3) + (bid >> 3) : bid;
    if (u < ATT_UNITS) att_issue(qkv, u, tid, wave, l15, lq, kreg, vreg, qn);
    for (; u < ATT_UNITS; u += G) {
        const AttUnit U = att_decode(u);
#pragma unroll
        for (int i = 0; i < 8; ++i) *(LAS u32x4*)(Ks + ((tid >> 4) + 32 * i) * ATT_KP + (tid & 15) * 16) = kreg[i];
#pragma unroll
        for (int i = 0; i < 8; ++i) *(LAS u32x4*)(Vt + ((tid >> 4) + 32 * i) * ATT_VP + (tid & 15) * 16) = vreg[i];
        bf16x8 qf[4];
#pragma unroll
        for (int es = 0; es < 4; ++es) qf[es] = __builtin_bit_cast(bf16x8, qn[es]);
        __syncthreads();
        if (u + G < ATT_UNITS) att_issue(qkv, u + G, tid, wave, l15, lq, kreg, vreg, qn);
        f32x4 S[10];
#pragma unroll
        for (int kk = 0; kk < 10; ++kk) { f32x4 acc = {0.f, 0.f, 0.f, 0.f}; const LAS unsigned char* kp = Ks + ((kb0 + kk) * 16 + l15) * ATT_KP + lq * 16;
#pragma unroll
            for (int es = 0; es < 4; ++es) acc = __builtin_amdgcn_mfma_f32_16x16x32_bf16(*(const LAS bf16x8*)(kp + es * 64), qf[es], acc, 0, 0, 0);
            S[kk] = acc; }
        const int qi = 16 * wave + l15, lo = (U.i0 == 0) ? 128 : qi, hi = qi + 128;
        float mx = -INFINITY;
#pragma unroll
        for (int kk = 0; kk < 10; ++kk)
#pragma unroll
            for (int j = 0; j < 4; ++j) { const int kj = 16 * (kb0 + kk) + 4 * lq + j; const float s = (kj >= lo && kj <= hi) ? S[kk][j] : -INFINITY; S[kk][j] = s; mx = fmaxf(mx, s); }
        mx = fmaxf(mx, __shfl_xor(mx, 16)); mx = fmaxf(mx, __shfl_xor(mx, 32));
        float den = 0.f;
#pragma unroll
        for (int kk = 0; kk < 10; ++kk)
#pragma unroll
            for (int j = 0; j < 4; ++j) { const float p = fexp(S[kk][j] - mx); S[kk][j] = p; den += p; }
        den += __shfl_xor(den, 16); den += __shfl_xor(den, 32);
        f32x4 O[8];
#pragma unroll
        for (int dvb = 0; dvb < 8; ++dvb) O[dvb] = (f32x4){0.f, 0.f, 0.f, 0.f};
#pragma unroll
        for (int sp = 0; sp < 5; ++sp) {
            u32x4 pw; pw.x = pk2(S[2 * sp][0], S[2 * sp][1]); pw.y = pk2(S[2 * sp][2], S[2 * sp][3]); pw.z = pk2(S[2 * sp + 1][0], S[2 * sp + 1][1]); pw.w = pk2(S[2 * sp + 1][2], S[2 * sp + 1][3]);
            const bf16x8 pf = __builtin_bit_cast(bf16x8, pw);
            const unsigned va = (unsigned)(size_t)(Vt + (32 * ((kb0 >> 1) + sp) + 4 * lq + (l15 >> 2)) * ATT_VP + (l15 & 3) * 8);
#pragma unroll
            for (int hb = 0; hb < 2; ++hb) {
                u32x2 t0[4], t1[4];
                const unsigned vb = va + hb * 128;
                asm volatile(
                    "ds_read_b64_tr_b16 %0, %8 offset:0\n\tds_read_b64_tr_b16 %1, %8 offset:32\n\tds_read_b64_tr_b16 %2, %8 offset:64\n\tds_read_b64_tr_b16 %3, %8 offset:96\n\t"
                    "ds_read_b64_tr_b16 %4, %8 offset:4608\n\tds_read_b64_tr_b16 %5, %8 offset:4640\n\tds_read_b64_tr_b16 %6, %8 offset:4672\n\tds_read_b64_tr_b16 %7, %8 offset:4704\n\t"
                    "s_waitcnt lgkmcnt(0)"
                    : "=&v"(t0[0]), "=&v"(t0[1]), "=&v"(t0[2]), "=&v"(t0[3]), "=&v"(t1[0]), "=&v"(t1[1]), "=&v"(t1[2]), "=&v"(t1[3])
                    : "v"(vb) : "memory");
#pragma unroll
                for (int d4 = 0; d4 < 4; ++d4) { const int dvb = 4 * hb + d4; u32x4 vw; vw.x = t0[d4].x; vw.y = t0[d4].y; vw.z = t1[d4].x; vw.w = t1[d4].y;
                    O[dvb] = __builtin_amdgcn_mfma_f32_16x16x32_bf16(__builtin_bit_cast(bf16x8, vw), pf, O[dvb], 0, 0, 0); }
            }
        }
        const float rden = 1.0f / den; const size_t tok = U.tokbase + (size_t)(U.i0 + qi) * U.d;
#pragma unroll
        for (int dvb = 0; dvb < 8; ++dvb) { u32x2 w; w.x = pk2(O[dvb][0] * rden, O[dvb][1] * rden); w.y = pk2(O[dvb][2] * rden, O[dvb][3] * rden);
            *(u32x2*)(ao + tok * AW + U.head * 128 + dvb * 16 + 4 * lq) = w; }
        if (lq == 0) lse[tok * 12 + U.head] = mx + __logf(den);
        __syncthreads();
    }
}
__device__ __forceinline__ void phase_attn_combine(const Args& a, int G, int bid, bool dry, int wave_sgpr) {
    int tid_ = (wave_sgpr * 64 + (int)__builtin_amdgcn_mbcnt_hi(~0u, __builtin_amdgcn_mbcnt_lo(~0u, 0u))); asm volatile("" : "+v"(tid_)); const int tid = tid_, lane = tid & 63, wave = __builtin_amdgcn_readfirstlane(tid >> 6);
    const int gw = bid * NWAVES + wave, NGW = G * NWAVES, hq = lane >> 4;
    bf16_t* ao = (bf16_t*)(a.ws + WS_AO); const float* lse = (const float*)(a.ws + WS_BA);
    for (int m = gw; m < MTOK; m += NGW) {
        const float l0 = lse[(size_t)m * 12 + hq], l1 = lse[(size_t)m * 12 + 4 + hq], l2 = lse[(size_t)m * 12 + 8 + hq];
        const float lm = fmaxf(l0, fmaxf(l1, l2)); const float e0 = fexp(l0 - lm), e1 = fexp(l1 - lm), e2 = fexp(l2 - lm), rs = 1.0f / (e0 + e1 + e2);
        const float al[3] = {e0 * rs, e1 * rs, e2 * rs};
#pragma unroll
        for (int i = 0; i < 3; ++i) { u32x4* p = (u32x4*)(ao + (size_t)m * AW + (lane + 64 * i) * 8); const u32x4 w = *p; const float s = al[i]; u32x4 o;
            o.x = pk2(bf_lo(w.x) * s, bf_hi(w.x) * s); o.y = pk2(bf_lo(w.y) * s, bf_hi(w.y) * s); o.z = pk2(bf_lo(w.z) * s, bf_hi(w.z) * s); o.w = pk2(bf_lo(w.w) * s, bf_hi(w.w) * s); if (!dry) *p = o; }
    }
}


constexpr int GD_P = 272, GD_KTP = 136, GD_QKP = 144, GD_OTP = 132;
constexpr int GD_QN = 0, GD_KN = 17408, GD_VS = 34816, GD_KT = 52224, GD_ST = 69632, GD_GATE = 104448, GD_CW = 105728, GD_RAW = 111872;
constexpr int GD_QKD = GD_RAW, GD_LM = GD_RAW + 9216, GD_OT = GD_RAW + 9216;
constexpr int GD_LB = GD_RAW + 25600, GD_LBP = 136, GD_TDR = GD_LB + 64 * GD_LBP, GD_TDC = GD_TDR + 2048;
static_assert(GD_TDC + 2048 <= GD_RAW + 3 * 67 * 256, "gdn lds map 2");
typedef short bf16x4 __attribute__((ext_vector_type(4)));
__device__ __forceinline__ bf16x4 pack4(f32x4 v) { u32x2 w; w.x = pk2(v[0], v[1]); w.y = pk2(v[2], v[3]); return __builtin_bit_cast(bf16x4, w); }
static_assert(GD_RAW + 3 * 67 * 256 <= LDS_BYTES && GD_OT + 64 * GD_OTP * 4 <= GD_RAW + 3 * 67 * 256, "gdn lds map");
#define LAUNDER(p) asm volatile("" : "+v"(p))
template <int CTRL> __device__ __forceinline__ float dpp_mov(float v) { return __builtin_bit_cast(float, __builtin_amdgcn_update_dpp(0, __builtin_bit_cast(int, v), CTRL, 0xf, 0xf, false)); }
__device__ __forceinline__ float row_sum16(float v) {
    v += dpp_mov<0x128>(v); v += dpp_mov<0x124>(v); v += dpp_mov<0x122>(v); v += dpp_mov<0x121>(v); return v; }
#define XB_TMO      128
#define XB_XCNT(j)  (256  + 64 * (j))
#define XB_XSUB(j)  (1280 + 64 * (j))
#define XB_XGEN(j)  (2304 + 64 * (j))
#define XB_TOP      3328
#define XB_TOPGEN   3392
#define XCD_BAR_WORDS 3456
#define XB_SPIN_CAP (1u << 18)

__device__ __forceinline__ unsigned xb_ld(unsigned* p)              { return __hip_atomic_load(p, __ATOMIC_RELAXED, __HIP_MEMORY_SCOPE_AGENT); }
__device__ __forceinline__ unsigned xb_add(unsigned* p, unsigned v) { return __hip_atomic_fetch_add(p, v, __ATOMIC_RELAXED, __HIP_MEMORY_SCOPE_AGENT); }
__device__ __forceinline__ unsigned xb_xcc_id() { return (unsigned)__builtin_amdgcn_s_getreg((3 << 11) | 20) & 0xFu; }
#define XB_SPIN(cond, bar) do { unsigned _sp = 0; while (cond) { __builtin_amdgcn_s_sleep(1); \
    if ((++_sp & 255u) == 0u) { if (xb_ld(&(bar)[XB_TMO])) break; if (_sp > XB_SPIN_CAP) { atomicAdd(&(bar)[XB_TMO], 1u); break; } } } } while (0)

struct XcdBarrier {
    unsigned* bar; unsigned x;
    volatile LAS unsigned* st;
};

__device__ __forceinline__ XcdBarrier xcd_barrier_post(unsigned* bar, volatile LAS unsigned* st, bool is_t0) {
    XcdBarrier b; b.bar = bar; b.x = xb_xcc_id(); b.st = st;
    if (is_t0) (void)xb_add(&bar[XB_XCNT(b.x)], 1u);
    return b;
}
__device__ __forceinline__ void xcd_barrier_complete(unsigned* bar, unsigned x, unsigned& nloc, unsigned& nx) {
    const unsigned G = gridDim.x * gridDim.y * gridDim.z;
    unsigned sum, cnt, mine, sp = 0u;
    for (;;) {
        sum = 0u; cnt = 0u; mine = 0u;
#pragma unroll
        for (unsigned j = 0; j < 16; ++j) { const unsigned c = xb_ld(&bar[XB_XCNT(j)]); sum += c; cnt += (c > 0u) ? 1u : 0u; mine = (j == x) ? c : mine; }
        if (sum == G) break;
        __builtin_amdgcn_s_sleep(1);
        if ((++sp & 255u) == 0u) { if (xb_ld(&bar[XB_TMO])) break; if (sp > XB_SPIN_CAP) { atomicAdd(&bar[XB_TMO], 1u); break; } }
    }
    nloc = mine > 0u ? mine : 1u; nx = cnt > 0u ? cnt : 1u;
}

__device__ __forceinline__ void xcd_barrier(const XcdBarrier& b, bool is_t0) {
    asm volatile("s_waitcnt vmcnt(0)" ::: "memory");
    __syncthreads();
    if (is_t0) {
        unsigned* bar = b.bar;
        __builtin_amdgcn_s_waitcnt(0);
        unsigned nloc = b.st[0], nx = b.st[1];
        if (nloc == 0u) { xcd_barrier_complete(bar, b.x, nloc, nx); b.st[0] = nloc; b.st[1] = nx; }
        const unsigned old = xb_add(&bar[XB_XSUB(b.x)], 1u);
        const unsigned gen = old / nloc;
        if (old + 1u == (gen + 1u) * nloc) {
            __builtin_amdgcn_fence(__ATOMIC_RELEASE, "agent");
            asm volatile("s_waitcnt vmcnt(0)" ::: "memory");
            const unsigned og = xb_add(&bar[XB_TOP], 1u);
            const unsigned tg = og / nx;
            if (og + 1u == (tg + 1u) * nx) xb_add(&bar[XB_TOPGEN], 1u);
            else XB_SPIN(xb_ld(&bar[XB_TOPGEN]) == tg, bar);
            __builtin_amdgcn_fence(__ATOMIC_ACQUIRE, "agent");
            xb_add(&bar[XB_XGEN(b.x)], 1u);
            asm volatile("s_waitcnt vmcnt(0)" ::: "memory");
        } else {
            XB_SPIN(xb_ld(&bar[XB_XGEN(b.x)]) == gen, bar);
            __builtin_amdgcn_fence(__ATOMIC_ACQUIRE, "agent");
            asm volatile("s_waitcnt vmcnt(0)" ::: "memory");
        }
    }
    __syncthreads();
}


__device__ __forceinline__ void phase_gdn_pre(const Args& a, int ib_, int wave_sgpr, int s_lo, int nseg, int wg0, int nwg) {
    const int bid = blockIdx.x - wg0, G = nwg;
    int tid_ = (wave_sgpr * 64 + (int)__builtin_amdgcn_mbcnt_hi(~0u, __builtin_amdgcn_mbcnt_lo(~0u, 0u))); asm volatile("" : "+v"(tid_)); const int tid = tid_, lane = tid & 63, wave = __builtin_amdgcn_readfirstlane(tid >> 6);
    const int gw = bid * NWAVES + wave, NGW = G * NWAVES, k = lane >> 4, grp = lane & 15;
    bf16_t* proj = (bf16_t*)(a.ws + WS_BIG); float* ba = (float*)(a.ws + WS_BA); const bf16_t* halo = (const bf16_t*)a.out;
    const float* cw = a.gdn_conv_w + (size_t)ib_ * 4 * GCONV;
#pragma unroll 1
    for (int item = gw; item < NB * nseg * 32; item += NGW) {
        const int h = item & 31, sq_ = item >> 5, bb_ = sq_ / nseg, seg = bb_ * 64 + s_lo + (sq_ - bb_ * nseg);
        const int type = (h < 8) ? 0 : (h < 16 ? 1 : 2), hv = h - 16;
        const int col = ((h < 8) ? h * 128 : (h < 16 ? GKD + (h - 8) * 128 : 2 * GKD + hv * 128)) + grp * 8;
        float aexp = 0.f, dtb = 0.f; if (type == 2) { aexp = fexp(a.gdn_a_log[ib_ * 16 + hv]); dtb = a.gdn_dt_bias[ib_ * 16 + hv]; }
        const size_t mrow0 = (size_t)seg * 64 + 16 * k; const int run = (int)(mrow0 >> 4);
        bf16_t* p = proj + mrow0 * PPITCH + col;
        u32x4 rows[19];
#pragma unroll
        for (int j = 0; j < 3; ++j) rows[j] = ((mrow0 & (SEQ - 1)) != 0) ? *(const u32x4*)(halo + ((size_t)(run - 1) * 3 + j) * GCONV + col) : (u32x4){0u, 0u, 0u, 0u};
#pragma unroll
        for (int s = 0; s < 16; ++s) rows[3 + s] = *(const u32x4*)(p + (size_t)s * PPITCH);
        f32x4 wgt[4][2];
#pragma unroll
        for (int j = 0; j < 4; ++j) { wgt[j][0] = *(const f32x4*)(cw + (size_t)j * GCONV + col); wgt[j][1] = *(const f32x4*)(cw + (size_t)j * GCONV + col + 4); }
        float bl[16], al[16];
        if (type == 2 && grp == 0) {
#pragma unroll
            for (int s = 0; s < 16; ++s) { bl[s] = ba[(mrow0 + s) * 32 + hv]; al[s] = ba[(mrow0 + s) * 32 + 16 + hv]; }
        }
#define UNPK8(dst, v) do { dst[0] = bf_lo(v.x); dst[1] = bf_hi(v.x); dst[2] = bf_lo(v.y); dst[3] = bf_hi(v.y); dst[4] = bf_lo(v.z); dst[5] = bf_hi(v.z); dst[6] = bf_lo(v.w); dst[7] = bf_hi(v.w); } while (0)
        float w3[8], w2[8], w1[8];
        UNPK8(w3, rows[0]); UNPK8(w2, rows[1]); UNPK8(w1, rows[2]);
#pragma unroll
        for (int s = 0; s < 16; ++s) {
            float w0[8]; UNPK8(w0, rows[3 + s]);
            float y[8], ss = 0.f;
#pragma unroll
            for (int q = 0; q < 8; ++q) { const float v = wgt[0][q >> 2][q & 3] * w3[q] + wgt[1][q >> 2][q & 3] * w2[q] + wgt[2][q >> 2][q & 3] * w1[q] + wgt[3][q >> 2][q & 3] * w0[q];
                y[q] = silu_f(v); ss += y[q] * y[q]; w3[q] = w2[q]; w2[q] = w1[q]; w1[q] = w0[q]; }
            float mul = 1.0f;
            if (type < 2) { ss = row_sum16(ss); mul = rsqrtf(ss + 1e-6f); if (type == 0) mul *= 0.08838834764831845f; }
            u32x4 o; o.x = pk2(y[0] * mul, y[1] * mul); o.y = pk2(y[2] * mul, y[3] * mul); o.z = pk2(y[4] * mul, y[5] * mul); o.w = pk2(y[6] * mul, y[7] * mul);
            *(u32x4*)(p + (size_t)s * PPITCH) = o;
        }
#undef UNPK8
        if (type == 2 && grp == 0) {
#pragma unroll
            for (int s = 0; s < 16; ++s) { const float x = al[s] + dtb; const float sp = (x > 20.f) ? x : log1pf(fexp(x));
                ba[(mrow0 + s) * 32 + hv] = 1.0f / (1.0f + fexp(-bl[s])); ba[(mrow0 + s) * 32 + 16 + hv] = -aexp * sp; }
        }
    }
}
__device__ __forceinline__ int perm_pos(int j) { return (j & ~31) + 8 * ((j & 15) >> 2) + 4 * ((j >> 4) & 1) + (j & 3); }
__device__ __forceinline__ float bf1(unsigned short h) { return __uint_as_float((unsigned)h << 16); }
__device__ __forceinline__ unsigned short f2bf(float f) { return (unsigned short)(pk2(f, 0.f) & 0xffffu); }

__device__ __forceinline__ void gdn_issue(const bf16_t* proj, const float* ba, int b, int hv, int c, int tid, u32x4 (&raw)[7], float& bl, float& al) {
    const u32x4 zero = {0u, 0u, 0u, 0u}; const int hk = hv >> 1;
    asm volatile("" : "+v"(tid));
#pragma unroll
    for (int i = 0; i < 7; ++i) {
        const int id = (tid - 64) + 448 * i; raw[i] = zero;
        if (id < 3072) { const int tens = id >> 10, cc = (id >> 6) & 15, row = id & 63;
            const int col = (tens == 0 ? hk * 128 : (tens == 1 ? GKD + hk * 128 : 2 * GKD + hv * 128)) + cc * 8;
            raw[i] = *(const u32x4*)(proj + (size_t)(b * SEQ + c * 64 + row) * PPITCH + col); }
    }
    bl = 0.f; al = 0.f;
    if (tid < 128) { const size_t m = (size_t)b * SEQ + c * 64 + (tid - 64); bl = ba[m * 32 + hv]; al = ba[m * 32 + 16 + hv]; }
}

__device__ __forceinline__ void phase_gdn(const Args& a, LAS unsigned char* lds, int G, int bid, int ib_, bool dry, int wave_sgpr, const XcdBarrier& xbar, bool is_t0, bool overlap) {
    int tid_ = (wave_sgpr * 64 + (int)__builtin_amdgcn_mbcnt_hi(~0u, __builtin_amdgcn_mbcnt_lo(~0u, 0u))); asm volatile("" : "+v"(tid_)); const int tid = tid_, lane = tid & 63, wave = __builtin_amdgcn_readfirstlane(tid >> 6);
    const int l15 = lane & 15, lq = lane >> 4;
    bf16_t* proj = (bf16_t*)(a.ws + WS_BIG); const float* ba = (const float*)(a.ws + WS_BA);
    const float* gnw = a.gdn_norm_w + ib_ * 128;
    LAS float* gate = (LAS float*)(lds + GD_GATE);
    LAS float* Lm = (LAS float*)(lds + GD_LM); LAS float* Ot = (LAS float*)(lds + GD_OT);
    for (int unit = bid; unit < NB * 16; unit += G) {
        const int b = unit >> 4, hv = unit & 15, hk = hv >> 1;
        for (int i = tid; i < 128 * GD_P / 4; i += NTHREADS) ((LAS unsigned*)(lds + GD_ST))[i] = 0u;
        f32x4 Sacc[8];
#pragma unroll
        for (int eb = 0; eb < 8; ++eb) Sacc[eb] = (f32x4){0.f, 0.f, 0.f, 0.f};
        u32x4 raw[7]; float bl = 0.f, al = 0.f;
#pragma unroll
        for (int i = 0; i < 7; ++i) raw[i] = (u32x4){0u, 0u, 0u, 0u};
        if (wave >= 1) gdn_issue(proj, ba, b, hv, 0, tid, raw, bl, al);
        { int tq = tid; asm volatile("" : "+v"(tq)); const int lane_c = tq & 63;
        const float bl_c = bl, al_c = al;
        if (wave >= 1) {
#pragma unroll
            for (int i = 0; i < 7; ++i) {
                const int id = (tq - 64) + 448 * i;
                if (id < 3072) { const int tens = id >> 10, cc = (id >> 6) & 15, row = id & 63; const u32x4 w = raw[i];
                    *(LAS u32x4*)(lds + (tens == 0 ? GD_QN : (tens == 1 ? GD_KN : GD_VS)) + row * GD_P + cc * 16) = w;
                }
            }
        }
        if (wave == 1) {
            const float beta = bl_c; float v = al_c;
#pragma unroll
            for (int off = 1; off < 64; off <<= 1) { const float t = __shfl_up(v, off); if (lane_c >= off) v += t; }
            const float g63 = __shfl(v, 63), eg = fexp(v);
            gate[lane_c] = beta; gate[64 + lane_c] = v; gate[128 + lane_c] = eg; gate[192 + lane_c] = fexp(g63 - v); gate[256 + lane_c] = beta * eg;
        }
        }
        __syncthreads();
        for (int c = 0; c < SEQ / 64; ++c) {
            if (overlap && c >= 15 && c < 63 && ((c - 15) & 7) == 0) xcd_barrier(xbar, is_t0);
            int tq = tid; asm volatile("" : "+v"(tq)); const int lane_c = tq & 63;
            {
                const int ib = wave & 3; const bool isq = wave >= 4;
                const LAS unsigned char* abase = lds + (isq ? GD_QN : GD_KN) + (16 * ib + l15) * GD_P + lq * 16; LAUNDER(abase);
                const LAS unsigned char* kbase = lds + GD_KN + l15 * GD_P + lq * 16; LAUNDER(kbase);
                const LAS float* gt = gate; LAUNDER(gt);
                LAS float* lmw = Lm + (16 * ib + 4 * lq) * 64 + l15; LAUNDER(lmw);
                LAS unsigned char* lbw = lds + GD_LB + (16 * ib + 4 * lq) * GD_LBP + l15 * 2; LAUNDER(lbw);
                LAS unsigned char* qkw = lds + GD_QKD + (16 * ib + 4 * lq) * GD_QKP + perm_pos(l15) * 2; LAUNDER(qkw);
                bf16x8 af[4];
#pragma unroll
                for (int es = 0; es < 4; ++es) af[es] = *(const LAS bf16x8*)(abase + es * 64);
                float gi[4], bi[4];
#pragma unroll
                for (int jj = 0; jj < 4; ++jj) { gi[jj] = gt[64 + 16 * ib + 4 * lq + jj]; bi[jj] = gt[16 * ib + 4 * lq + jj]; }
#pragma unroll
                for (int jb = 0; jb < 4; ++jb) {
                    const int j = 16 * jb + l15;
                    if (jb <= ib) {
                        f32x4 acc = {0.f, 0.f, 0.f, 0.f}; const LAS unsigned char* bbase = kbase + 16 * jb * GD_P;
#pragma unroll
                        for (int es = 0; es < 4; ++es) acc = __builtin_amdgcn_mfma_f32_16x16x32_bf16(af[es], *(const LAS bf16x8*)(bbase + es * 64), acc, 0, 0, 0);
                        const float gj = gt[64 + j];
#pragma unroll
                        for (int jj = 0; jj < 4; ++jj) { const int i = 16 * ib + 4 * lq + jj;
                            if (!isq) { const float v = (i > j) ? bi[jj] * acc[jj] * fexp(gi[jj] - gj) : 0.f; lmw[jj * 64 + 16 * jb] = v; *(LAS unsigned short*)(lbw + jj * GD_LBP + 32 * jb) = f2bf(v); }
                            else { const float v = (i >= j) ? acc[jj] * fexp(gi[jj] - gj) : 0.f; *(LAS unsigned short*)(qkw + jj * GD_QKP + (32 * (jb >> 1) + 4 * (jb & 1)) * 2) = f2bf(v); } }
                    } else if (isq) {
#pragma unroll
                        for (int jj = 0; jj < 4; ++jj) *(LAS unsigned short*)(qkw + jj * GD_QKP + (32 * (jb >> 1) + 4 * (jb & 1)) * 2) = 0;
                    }
                }
            }
            __syncthreads();
            if (wave == 0) {
                const int g = lane_c >> 4, cc = lane_c & 15;
                const LAS float* lmd = Lm + (16 * g) * 64 + 16 * g; LAUNDER(lmd);
                f32x2 X[8];
#pragma unroll
                for (int p = 0; p < 8; ++p) X[p] = (f32x2){0.f, 0.f};
#pragma unroll
                for (int r = 0; r < 16; ++r) {
                    const int nq = (r + 3) / 4;
                    f32x4 l4[4];
#pragma unroll
                    for (int q = 0; q < nq; ++q) l4[q] = *(const LAS f32x4*)(lmd + r * 64 + 4 * q);
                    f32x2 acc0 = {0.f, 0.f}, acc1 = {0.f, 0.f};
#pragma unroll
                    for (int q = 0; q < nq; ++q) {
                        acc0 += (f32x2){l4[q][0], l4[q][1]} * X[2 * q];
                        if (2 * q + 1 < (r + 1) / 2) acc1 += (f32x2){l4[q][2], l4[q][3]} * X[2 * q + 1];
                    }
                    const float x = ((cc == r) ? 1.0f : 0.0f) - ((acc0.x + acc0.y) + (acc1.x + acc1.y));
                    if (r & 1) X[r >> 1].y = x; else X[r >> 1].x = x;
                }
                LAS unsigned char* tdr = lds + GD_TDR + g * 512 + cc * 2; LAUNDER(tdr);
#pragma unroll
                for (int r = 0; r < 16; ++r) *(LAS unsigned short*)(tdr + r * 32) = f2bf((r & 1) ? X[r >> 1].y : X[r >> 1].x);
                u32x4 c0, c1;
                c0.x = pk2(X[0].x, X[0].y); c0.y = pk2(X[1].x, X[1].y); c0.z = pk2(X[2].x, X[2].y); c0.w = pk2(X[3].x, X[3].y);
                c1.x = pk2(X[4].x, X[4].y); c1.y = pk2(X[5].x, X[5].y); c1.z = pk2(X[6].x, X[6].y); c1.w = pk2(X[7].x, X[7].y);
                LAS unsigned char* tdc = lds + GD_TDC + g * 512 + cc * 32; LAUNDER(tdc);
                *(LAS u32x4*)tdc = c0; *(LAS u32x4*)(tdc + 16) = c1;
                __syncthreads();
                { const int c = lane_c; const float sb = gate[c], sw = gate[256 + c];
                  LAS unsigned char* tw = lds + GD_LM + (16 * g) * 128 + perm_pos(c) * 2; LAUNDER(tw);
#pragma unroll
                  for (int r = 0; r < 16; ++r) { const float x = (r & 1) ? X[r >> 1].y : X[r >> 1].x;
                      *(LAS unsigned short*)(tw + r * 128) = f2bf(x * sb); *(LAS unsigned short*)(tw + 8192 + r * 128) = f2bf(x * sw); } }
#pragma unroll
                for (int i = 0; i < 7; ++i) raw[i] = (u32x4){0u, 0u, 0u, 0u};
            } else {
                if (c + 1 < SEQ / 64) gdn_issue(proj, ba, b, hv, c + 1, tq, raw, bl, al);
                __syncthreads();
            }
            if (wave < 3) {
                const int c = 16 * wave + l15; const float sb = gate[c], sw = gate[256 + c];
                const LAS unsigned char* lbb = lds + GD_LB + l15 * GD_LBP + lq * 8; LAUNDER(lbb);
                const LAS unsigned char* tdb = lds + GD_TDR + l15 * 32 + lq * 8; LAUNDER(tdb);
                LAS unsigned char* tw = lds + GD_LM + (4 * lq) * 128 + perm_pos(c) * 2; LAUNDER(tw);
                bf16x4 Bop[4]; f32x4 Tb4[4];
#pragma unroll
                for (int i = 0; i < 4; ++i) { Bop[i] = (bf16x4){0, 0, 0, 0}; Tb4[i] = (f32x4){0.f, 0.f, 0.f, 0.f}; }
#pragma unroll
                for (int j = 0; j < 3; ++j) if (wave == j) {
                    Bop[j] = *(const LAS bf16x4*)(tdb + (GD_TDC - GD_TDR) + j * 512);
#pragma unroll
                    for (int i = j + 1; i < 4; ++i) {
                        f32x4 S = {0.f, 0.f, 0.f, 0.f};
#pragma unroll
                        for (int k = j; k < i; ++k) S = __builtin_amdgcn_mfma_f32_16x16x16bf16_1k(*(const LAS bf16x4*)(lbb + 16 * i * GD_LBP + 32 * k), Bop[k], S, 0, 0, 0);
                        const f32x4 Tn = __builtin_amdgcn_mfma_f32_16x16x16bf16_1k(*(const LAS bf16x4*)(tdb + i * 512), pack4(S), (f32x4){0.f, 0.f, 0.f, 0.f}, 0, 0, 0);
                        Tb4[i] = -Tn; Bop[i] = pack4(Tb4[i]);
#pragma unroll
                        for (int jj = 0; jj < 4; ++jj) { *(LAS unsigned short*)(tw + (16 * i + jj) * 128) = f2bf(Tb4[i][jj] * sb); *(LAS unsigned short*)(tw + 8192 + (16 * i + jj) * 128) = f2bf(Tb4[i][jj] * sw); }
                    }
                }
            } else if (wave == 3) {
                const int row = lane_c, ibz = row >> 4;
                for (int j = ibz + 1; j < 4; ++j)
#pragma unroll
                    for (int t = 0; t < 4; ++t) { LAS unsigned char* zp = lds + GD_LM + row * 128 + (32 * (j >> 1) + 8 * t + 4 * (j & 1)) * 2;
                        *(LAS u32x2*)zp = (u32x2){0u, 0u}; *(LAS u32x2*)(zp + 8192) = (u32x2){0u, 0u}; }
            }
            __syncthreads();
            u32x4 zreg[2];
#pragma unroll
            for (int i = 0; i < 2; ++i) zreg[i] = *(const u32x4*)(proj + (size_t)(b * SEQ + c * 64 + (tq >> 4) + 32 * i) * PPITCH + 2 * GKD + GVD + hv * 128 + (tq & 15) * 8);
            f32x4 vn[4];
            {
                const LAS unsigned char* tbb = lds + GD_LM + l15 * 128 + lq * 16; LAUNDER(tbb);
                LAS unsigned char* wmw = lds + GD_KT + l15 * GD_P + (16 * wave + 4 * lq) * 2; LAUNDER(wmw);
                bf16x8 kf[2], vf[2];
                {
                    const unsigned ka = (unsigned)(size_t)(lds + GD_KN + (4 * lq + (l15 >> 2)) * GD_P + (16 * wave + 4 * (l15 & 3)) * 2);
                    u32x2 r0, r1, r2, r3, r4, r5, r6, r7;
                    asm volatile("ds_read_b64_tr_b16 %0, %8 offset:0\n\tds_read_b64_tr_b16 %1, %8 offset:4352\n\tds_read_b64_tr_b16 %2, %8 offset:8704\n\tds_read_b64_tr_b16 %3, %8 offset:13056\n\t"
                                 "ds_read_b64_tr_b16 %4, %8 offset:17408\n\tds_read_b64_tr_b16 %5, %8 offset:21760\n\tds_read_b64_tr_b16 %6, %8 offset:26112\n\tds_read_b64_tr_b16 %7, %8 offset:30464\n\t"
                                 "s_waitcnt lgkmcnt(0)"
                                 : "=&v"(r0), "=&v"(r1), "=&v"(r2), "=&v"(r3), "=&v"(r4), "=&v"(r5), "=&v"(r6), "=&v"(r7) : "v"(ka) : "memory");
                    u32x4 w0; w0.x = r0.x; w0.y = r0.y; w0.z = r1.x; w0.w = r1.y; kf[0] = __builtin_bit_cast(bf16x8, w0);
                    u32x4 w1; w1.x = r2.x; w1.y = r2.y; w1.z = r3.x; w1.w = r3.y; kf[1] = __builtin_bit_cast(bf16x8, w1);
                    u32x4 w2; w2.x = r4.x; w2.y = r4.y; w2.z = r5.x; w2.w = r5.y; vf[0] = __builtin_bit_cast(bf16x8, w2);
                    u32x4 w3; w3.x = r6.x; w3.y = r6.y; w3.z = r7.x; w3.w = r7.y; vf[1] = __builtin_bit_cast(bf16x8, w3);
                }
#pragma unroll
                for (int ib = 0; ib < 4; ++ib) {
                    f32x4 wa = {0.f, 0.f, 0.f, 0.f}; vn[ib] = (f32x4){0.f, 0.f, 0.f, 0.f};
#pragma unroll
                    for (int s = 0; s < 2; ++s) {
                        wa = __builtin_amdgcn_mfma_f32_16x16x32_bf16(kf[s], *(const LAS bf16x8*)(tbb + 8192 + 16 * ib * 128 + 64 * s), wa, 0, 0, 0);
                        vn[ib] = __builtin_amdgcn_mfma_f32_16x16x32_bf16(*(const LAS bf16x8*)(tbb + 16 * ib * 128 + 64 * s), vf[s], vn[ib], 0, 0, 0);
                    }
                    u32x2 ww; ww.x = pk2(-wa[0], -wa[1]); ww.y = pk2(-wa[2], -wa[3]);
                    *(LAS u32x2*)(wmw + 16 * ib * GD_P) = ww;
                    __builtin_amdgcn_sched_barrier(0);
                }
            }
            __syncthreads();
            {
                const LAS unsigned char* stb = lds + GD_ST + (16 * wave + l15) * GD_P + lq * 16; LAUNDER(stb);
                const LAS unsigned char* wbb = lds + GD_KT + l15 * GD_P + lq * 16; LAUNDER(wbb);
                const LAS unsigned char* qbb = lds + GD_QN + l15 * GD_P + lq * 16; LAUNDER(qbb);
                const LAS float* gt = gate + 4 * lq; LAUNDER(gt);
                const LAS unsigned char* qkb = lds + GD_QKD + l15 * GD_QKP + lq * 16; LAUNDER(qkb);
                const unsigned kta = (unsigned)(size_t)(lds + GD_KN + (4 * lq + (l15 >> 2)) * GD_P + (4 * (l15 & 3)) * 2);
                LAS unsigned char* stw = lds + GD_ST + (16 * wave + l15) * GD_P + lq * 8; LAUNDER(stw);
                LAS float* otw = Ot + (4 * lq) * GD_OTP + 16 * wave + l15; LAUNDER(otw);
                bf16x8 sf[4];
#pragma unroll
                for (int es = 0; es < 4; ++es) sf[es] = *(const LAS bf16x8*)(stb + es * 64);
                f32x4 oa[4];
#pragma unroll
                for (int ib = 0; ib < 4; ++ib) {
                    oa[ib] = (f32x4){0.f, 0.f, 0.f, 0.f};
                    const LAS unsigned char* wb = wbb + 16 * ib * GD_P; const LAS unsigned char* qb = qbb + 16 * ib * GD_P;
#pragma unroll
                    for (int es = 0; es < 4; ++es) {
                        vn[ib] = __builtin_amdgcn_mfma_f32_16x16x32_bf16(*(const LAS bf16x8*)(wb + es * 64), sf[es], vn[ib], 0, 0, 0);
                        oa[ib] = __builtin_amdgcn_mfma_f32_16x16x32_bf16(*(const LAS bf16x8*)(qb + es * 64), sf[es], oa[ib], 0, 0, 0);
                    }
#pragma unroll
                    for (int jj = 0; jj < 4; ++jj) oa[ib][jj] *= gt[128 + 16 * ib + jj];
                    __builtin_amdgcn_sched_barrier(0);
                }
                bf16x8 bv[2], bvd[2];
#pragma unroll
                for (int s = 0; s < 2; ++s) {
                    u32x4 p, pd; float d0[4], d1[4];
#pragma unroll
                    for (int jj = 0; jj < 4; ++jj) { d0[jj] = gt[192 + 32 * s + jj]; d1[jj] = gt[192 + 32 * s + 16 + jj]; }
                    p.x = pk2(vn[2 * s][0], vn[2 * s][1]); p.y = pk2(vn[2 * s][2], vn[2 * s][3]); p.z = pk2(vn[2 * s + 1][0], vn[2 * s + 1][1]); p.w = pk2(vn[2 * s + 1][2], vn[2 * s + 1][3]);
                    pd.x = pk2(vn[2 * s][0] * d0[0], vn[2 * s][1] * d0[1]); pd.y = pk2(vn[2 * s][2] * d0[2], vn[2 * s][3] * d0[3]);
                    pd.z = pk2(vn[2 * s + 1][0] * d1[0], vn[2 * s + 1][1] * d1[1]); pd.w = pk2(vn[2 * s + 1][2] * d1[2], vn[2 * s + 1][3] * d1[3]);
                    bv[s] = __builtin_bit_cast(bf16x8, p); bvd[s] = __builtin_bit_cast(bf16x8, pd);
                }
#pragma unroll
                for (int ib = 0; ib < 4; ++ib)
#pragma unroll
                    for (int s = 0; s < 2; ++s)
                        oa[ib] = __builtin_amdgcn_mfma_f32_16x16x32_bf16(*(const LAS bf16x8*)(qkb + 16 * ib * GD_QKP + 64 * s), bv[s], oa[ib], 0, 0, 0);
                const float eg63 = gate[128 + 63];
#pragma unroll
                for (int eb = 0; eb < 8; ++eb) {
                    Sacc[eb] = Sacc[eb] * eg63;
                    { u32x2 r0, r1, r2, r3; const unsigned ke = kta + 32 * eb;
                      asm volatile("ds_read_b64_tr_b16 %0, %4 offset:0\n\tds_read_b64_tr_b16 %1, %4 offset:4352\n\tds_read_b64_tr_b16 %2, %4 offset:8704\n\tds_read_b64_tr_b16 %3, %4 offset:13056\n\ts_waitcnt lgkmcnt(0)"
                                   : "=&v"(r0), "=&v"(r1), "=&v"(r2), "=&v"(r3) : "v"(ke) : "memory");
                      u32x4 k0w; k0w.x = r0.x; k0w.y = r0.y; k0w.z = r1.x; k0w.w = r1.y; u32x4 k1w; k1w.x = r2.x; k1w.y = r2.y; k1w.z = r3.x; k1w.w = r3.y;
                      Sacc[eb] = __builtin_amdgcn_mfma_f32_16x16x32_bf16(__builtin_bit_cast(bf16x8, k0w), bvd[0], Sacc[eb], 0, 0, 0);
                      Sacc[eb] = __builtin_amdgcn_mfma_f32_16x16x32_bf16(__builtin_bit_cast(bf16x8, k1w), bvd[1], Sacc[eb], 0, 0, 0); }
                    u32x2 sw; sw.x = pk2(Sacc[eb][0], Sacc[eb][1]); sw.y = pk2(Sacc[eb][2], Sacc[eb][3]);
                    *(LAS u32x2*)(stw + 32 * eb) = sw;
                }
#pragma unroll
                for (int ib = 0; ib < 4; ++ib)
#pragma unroll
                    for (int jj = 0; jj < 4; ++jj) otw[(16 * ib + jj) * GD_OTP] = oa[ib][jj];
            }
            __syncthreads();
#pragma unroll
            for (int i = 0; i < 2; ++i) {
                const int tok = (tq >> 4) + 32 * i, grp = tq & 15;
                const f32x4 o0 = *(const LAS f32x4*)(Ot + tok * GD_OTP + grp * 8), o1 = *(const LAS f32x4*)(Ot + tok * GD_OTP + grp * 8 + 4);
                float ss = (o0[0] * o0[0] + o0[1] * o0[1]) + (o0[2] * o0[2] + o0[3] * o0[3]) + (o1[0] * o1[0] + o1[1] * o1[1]) + (o1[2] * o1[2] + o1[3] * o1[3]);
                ss = row_sum16(ss);
                const float rstd = rsqrtf(ss * (1.0f / 128.0f) + RMS_EPS);
                const u32x4 zw = zreg[i];
                const f32x4 w0 = *(const f32x4*)(gnw + grp * 8), w1 = *(const f32x4*)(gnw + grp * 8 + 4);
                u32x4 r;
                r.x = pk2(o0[0] * rstd * w0[0] * silu_f(bf_lo(zw.x)), o0[1] * rstd * w0[1] * silu_f(bf_hi(zw.x)));
                r.y = pk2(o0[2] * rstd * w0[2] * silu_f(bf_lo(zw.y)), o0[3] * rstd * w0[3] * silu_f(bf_hi(zw.y)));
                r.z = pk2(o1[0] * rstd * w1[0] * silu_f(bf_lo(zw.z)), o1[1] * rstd * w1[1] * silu_f(bf_hi(zw.z)));
                r.w = pk2(o1[2] * rstd * w1[2] * silu_f(bf_lo(zw.w)), o1[3] * rstd * w1[3] * silu_f(bf_hi(zw.w)));
                if (!dry) *(u32x4*)(proj + (size_t)(b * SEQ + c * 64 + tok) * PPITCH + 2 * GKD + GVD + hv * 128 + grp * 8) = r;
            }
            if (c + 1 < SEQ / 64) {
                const float bl_c = bl, al_c = al;
                if (wave >= 1) {
#pragma unroll
                    for (int i = 0; i < 7; ++i) {
                        const int id = (tq - 64) + 448 * i;
                        if (id < 3072) { const int tens = id >> 10, cc = (id >> 6) & 15, row = id & 63; const u32x4 w = raw[i];
                            *(LAS u32x4*)(lds + (tens == 0 ? GD_QN : (tens == 1 ? GD_KN : GD_VS)) + row * GD_P + cc * 16) = w;
                        }
                    }
                }
                if (wave == 1) {
                    const float beta = bl_c; float v = al_c;
#pragma unroll
                    for (int off = 1; off < 64; off <<= 1) { const float t = __shfl_up(v, off); if (lane_c >= off) v += t; }
                    const float g63 = __shfl(v, 63), eg = fexp(v);
                    gate[lane_c] = beta; gate[64 + lane_c] = v; gate[128 + lane_c] = eg; gate[192 + lane_c] = fexp(g63 - v); gate[256 + lane_c] = beta * eg;
                }
            }
            __syncthreads();
        }
    }
}

__device__ __forceinline__ void phase_final(const Args& a, int G, int bid, int wave_sgpr) {
    int tid_ = (wave_sgpr * 64 + (int)__builtin_amdgcn_mbcnt_hi(~0u, __builtin_amdgcn_mbcnt_lo(~0u, 0u))); asm volatile("" : "+v"(tid_)); const int tid = tid_, lane = tid & 63, wave = __builtin_amdgcn_readfirstlane(tid >> 6);
    const int gw = bid * NWAVES + wave, NGW = G * NWAVES;
    const u64* ssq = (const u64*)(a.ws + WS_SSQ) + (size_t)12 * MTOK; const bf16_t* xh = (const bf16_t*)(a.ws + WS_XB); const unsigned char* xl = a.ws + WS_XL;
    for (int m = gw; m < MTOK; m += NGW) {
        const float rstd = rstd_of(ssq, m);
#pragma unroll
        for (int j = 0; j < 2; ++j) {
            const size_t off = (size_t)m * DM + 8 * (lane + 64 * j);
            const u32x4 h = *(const u32x4*)(xh + off); const u32x2 l = *(const u32x2*)(xl + off);
            const f32x2 l0 = __builtin_amdgcn_cvt_pk_f32_fp8((int)l.x, false), l1 = __builtin_amdgcn_cvt_pk_f32_fp8((int)l.x, true), l2 = __builtin_amdgcn_cvt_pk_f32_fp8((int)l.y, false), l3 = __builtin_amdgcn_cvt_pk_f32_fp8((int)l.y, true);
            const f32x4 w0 = *(const f32x4*)(a.final_norm_w + 8 * (lane + 64 * j)), w1 = *(const f32x4*)(a.final_norm_w + 8 * (lane + 64 * j) + 4);
            f32x4 o0 = {bf_lo(h.x) + l0.x * 0.00390625f, bf_hi(h.x) + l0.y * 0.00390625f, bf_lo(h.y) + l1.x * 0.00390625f, bf_hi(h.y) + l1.y * 0.00390625f};
            f32x4 o1 = {bf_lo(h.z) + l2.x * 0.00390625f, bf_hi(h.z) + l2.y * 0.00390625f, bf_lo(h.w) + l3.x * 0.00390625f, bf_hi(h.w) + l3.y * 0.00390625f};
            *(f32x4*)(a.out + off) = o0 * rstd * w0; *(f32x4*)(a.out + off + 4) = o1 * rstd * w1;
        }
    }
}

constexpr int N_PHASES = 34;
__global__ void __launch_bounds__(NTHREADS, 2) fwd_kernel(Args a_in) {
    extern __shared__ __attribute__((aligned(16))) unsigned char lds_raw[];
    LAS unsigned char* lds = (LAS unsigned char*)lds_raw;
    cg::grid_group grid = cg::this_grid();
    const int wave_sgpr = __builtin_amdgcn_readfirstlane((int)(threadIdx.x >> 6));
    volatile LAS unsigned* xb_st = (volatile LAS unsigned*)(lds + LDS_BYTES - 8);
    if (threadIdx.x < 2) xb_st[threadIdx.x] = 0u;
    __syncthreads();
    const bool is_t0 = (wave_sgpr == 0) && (__builtin_amdgcn_mbcnt_hi(~0u, __builtin_amdgcn_mbcnt_lo(~0u, 0u)) == 0u);
    unsigned* xb_words = (unsigned*)(((const __attribute__((address_space(4))) Args*)__builtin_amdgcn_kernarg_segment_ptr())->ws + WS_XBAR);
    XcdBarrier xbar = xcd_barrier_post(xb_words, xb_st, is_t0);
    typedef const __attribute__((address_space(4))) Args* KArgs;
    const int ph_lo = ((KArgs)__builtin_amdgcn_kernarg_segment_ptr())->ph_lo, ph_hi = ((KArgs)__builtin_amdgcn_kernarg_segment_ptr())->ph_hi;
#pragma nounroll
    for (int ph = ph_lo; ph < ph_hi; ++ph) {
        KArgs ap = (KArgs)__builtin_amdgcn_kernarg_segment_ptr(); asm volatile("" : "+s"(ap));
        const Args a = *(const Args*)ap;
        int G = gridDim.x, bid = blockIdx.x; asm volatile("" : "+s"(G), "+s"(bid));
        bf16_t* Wb = (bf16_t*)(a.ws + WS_W); u64* ssq = (u64*)(a.ws + WS_SSQ); bf16_t* xb = (bf16_t*)(a.ws + WS_XB); bf16_t* big = (bf16_t*)(a.ws + WS_BIG);
        const int layer = (ph - 1) / 8, st = (ph - 1) % 8, im = layer >> 1; const bool is_gdn = layer & 1, mid = (ph > 0 && ph < N_PHASES - 1);
#ifndef PROBE_KIND
#define PROBE_KIND 0
#endif
        int nrep = 1;
        if (PROBE_KIND == 1 && mid && st != 3 && st != 4) nrep = 2;
        if (PROBE_KIND == 2 && mid && st == 4 && is_gdn) nrep = 2;
        if (PROBE_KIND == 3 && (ph == 0 || (mid && !is_gdn && (st == 3 || st == 4)))) nrep = 2;
        if (PROBE_KIND == 4 && mid && (st == 0 || st == 6)) nrep = 2;
#pragma nounroll
        for (int rp = 0; rp < nrep; ++rp) {
        const bool dry = (rp + 1 < nrep);
        if (rp > 0) xcd_barrier(xbar, is_t0);
        if (ph == 0) phase_prep(a, lds, G, bid, wave_sgpr);
        else if (ph == N_PHASES - 1) phase_final(a, G, bid, wave_sgpr);
        else {
            pg8::StaticOrder S;
            if (st == 0 || st == 6) {
                const int j = (st == 6);
                pg8::Gemm g{xb, Wb + W_FFNIN + (size_t)(layer * 2 + j) * SZ_FFNIN, MTOK, NFF, DM, DM}; S.init(MTOK, NFF, G, bid);
                EpiFfnIn E{big, ssq + (size_t)(layer * 3 + 2 * j) * MTOK};
                pg8::gemm_phase<EpiFfnIn, pg8::StaticOrder, true, true>(lds, g, S, E, wave_sgpr);
            } else if (st == 1 || st == 7 || st == 5) {
                pg8::Gemm g; EpiResid E; E.xin = a.x; E.first = (ph == 2); E.xh = xb; E.xl = a.ws + WS_XL;
                if (st == 5) {
                    if (!is_gdn) g = pg8::Gemm{(const bf16_t*)(a.ws + WS_AO), Wb + W_ATTNOUT + (size_t)im * SZ_ATTNOUT, MTOK, DM, AW, AW};
                    else g = pg8::Gemm{big + 2 * GKD + GVD, Wb + W_GDNOUT + (size_t)im * SZ_GDNOUT, MTOK, DM, GVD, PPITCH};
                    E.scale = 1.0f; E.ssqn = ssq + (size_t)(layer * 3 + 2) * MTOK;
                } else {
                    const int j = (st == 7);
                    g = pg8::Gemm{big, Wb + W_FFNOUT + (size_t)(layer * 2 + j) * SZ_FFNOUT, MTOK, DM, DFF, DFF};
                    E.scale = 0.5f; E.ssqn = ssq + (size_t)(j ? (layer + 1) * 3 : layer * 3 + 1) * MTOK;
                }
                if (dry) { E.scale = 0.f; E.ssqn = (u64*)(a.ws + WS_DUMMY); }
                S.init(MTOK, DM, G, bid);
                pg8::gemm_phase<EpiResid, pg8::StaticOrder, true, true>(lds, g, S, E, wave_sgpr);
            } else if (st == 2) {
                const u64* sq = ssq + (size_t)(layer * 3 + 1) * MTOK;
                if (!is_gdn) {
                    pg8::Gemm g{xb, Wb + W_ATTNIN + (size_t)im * SZ_ATTNIN, MTOK, NA, DM, DM}; S.init(MTOK, NA, G, bid);
                    EpiAttnIn E{big, sq, (const float*)(a.ws + WS_ROPE)};
                    pg8::gemm_phase<EpiAttnIn, pg8::StaticOrder, true, true>(lds, g, S, E, wave_sgpr);
                } else {
                    pg8::Gemm g{xb, Wb + W_GDNIN + (size_t)im * SZ_GDNIN, MTOK, NGP, DM, DM}; S.init(MTOK, NGP, G, bid);
                    EpiGdnIn E{big, (float*)(a.ws + WS_BA), sq, (bf16_t*)a.out};
                    pg8::gemm_phase<EpiGdnIn, pg8::StaticOrder, true, true>(lds, g, S, E, wave_sgpr);
                }
            } else if (st == 3) {
                if (!is_gdn) phase_attn(a, lds, G, bid, wave_sgpr);
                else { if (G >= 256) phase_gdn_pre(a, im, wave_sgpr, 0, 16, 0, G); else phase_gdn_pre(a, im, wave_sgpr, 0, 64, 0, G); }
            } else {
                if (!is_gdn) phase_attn_combine(a, G, bid, dry, wave_sgpr);
                else if (G >= 256) {
                    if (bid < NB * 16) phase_gdn(a, lds, G, bid, im, dry, wave_sgpr, xbar, is_t0, true);
                    else { for (int qd = 0; qd < 6; ++qd) { phase_gdn_pre(a, im, wave_sgpr, 16 + 8 * qd, 8, NB * 16, G - NB * 16); xcd_barrier(xbar, is_t0); } }
                } else phase_gdn(a, lds, G, bid, im, dry, wave_sgpr, xbar, is_t0, false);
            }
        }
        }
        if (ph + 1 < ph_hi) { if (ph_hi > (1 << 20)) grid.sync(); else xcd_barrier(xbar, is_t0); }
    }
}

#ifndef MK_ONE_LAUNCH
#define MK_ONE_LAUNCH 1
#endif
extern "C" void kernel_launch(void* const* d_in, const int* in_sizes, int n_in, void* d_out, int out_size, void* d_ws, size_t ws_size, hipStream_t stream) {
    static int grid = 0;
    if (grid == 0) {
        if (n_in != 13 || out_size != MTOK * DM || ws_size < WS_END) { fprintf(stderr, "kernel_launch: unexpected shapes (n_in %d out %d ws %zu)\n", n_in, out_size, ws_size); grid = -1; return; }
        int dev = 0, cus = 0, per_cu = 0;
        if (hipGetDevice(&dev) != hipSuccess || hipDeviceGetAttribute(&cus, hipDeviceAttributeMultiprocessorCount, dev) != hipSuccess) { grid = -1; return; }
        if (hipFuncSetAttribute((const void*)fwd_kernel, hipFuncAttributeMaxDynamicSharedMemorySize, LDS_BYTES) != hipSuccess) { fprintf(stderr, "kernel_launch: hipFuncSetAttribute failed\n"); grid = -1; return; }
        if (hipOccupancyMaxActiveBlocksPerMultiprocessor(&per_cu, (const void*)fwd_kernel, NTHREADS, LDS_BYTES) != hipSuccess || per_cu < 1) { fprintf(stderr, "kernel_launch: occupancy query says %d\n", per_cu); per_cu = 1; }
        (void)hipGetLastError();
        grid = cus * 1;
    }
    if (grid < 0) return;
    Args a{};
    a.x = (const float*)d_in[0]; a.norm_w = (const float*)d_in[1]; a.ffn_w_in = (const float*)d_in[2]; a.ffn_w_out = (const float*)d_in[3];
    a.attn_w_in = (const float*)d_in[4]; a.attn_w_out = (const float*)d_in[5]; a.gdn_w_in = (const float*)d_in[6]; a.gdn_conv_w = (const float*)d_in[7];
    a.gdn_a_log = (const float*)d_in[8]; a.gdn_dt_bias = (const float*)d_in[9]; a.gdn_norm_w = (const float*)d_in[10]; a.gdn_w_out = (const float*)d_in[11];
    a.final_norm_w = (const float*)d_in[12]; a.out = (float*)d_out; a.ws = (unsigned char*)d_ws;
    (void)hipMemsetAsync((unsigned char*)d_ws + WS_XBAR, 0, XCD_BAR_WORDS * sizeof(unsigned), stream);
#if MK_ONE_LAUNCH
    a.ph_lo = 0; a.ph_hi = N_PHASES;
    void* args[] = {&a};
    hipError_t e = hipLaunchCooperativeKernel((const void*)fwd_kernel, dim3(grid), dim3(NTHREADS), args, LDS_BYTES, stream);
    if (e != hipSuccess) fprintf(stderr, "cooperative launch failed: %s (grid %d)\n", hipGetErrorString(e), grid);
#else
    for (int ph = 0; ph < N_PHASES; ++ph) { a.ph_lo = ph; a.ph_hi = ph + 1; hipLaunchKernelGGL(fwd_kernel, dim3(grid), dim3(NTHREADS), LDS_BYTES, stream, a); }
#endif
}
```
